# Optimizing an MI355X kernel written in HIP

```python
import jax, jax.numpy as jnp
from jax import lax
import numpy as np

D_MODEL = 2048
BATCH = 8
SEQ = 2048
DEPTH = 1

MEM_LEN = 256
HEAD_DIM = 128
MOBA_HEADS = 8
MOBA_BLOCK = 256
MOBA_TOPK = 3
MOBA_Q_CHUNK = 16
DIL_CONFIGS = ((128, 1), (512, 4), (2048, 16))
DIL_HEADS_PER_GROUP = 4
MEM_HEADS = 4
MEM_HEAD_DIM = 256
ROPE_THETA = 10000.0
RMS_EPS = 1e-6
NEG = -1e30
N_BRANCH = 3

W_A = MOBA_HEADS * HEAD_DIM
W_B_QKV = len(DIL_CONFIGS) * DIL_HEADS_PER_GROUP * HEAD_DIM
W_B_OUT = DIL_HEADS_PER_GROUP * HEAD_DIM
W_M = MEM_HEADS * MEM_HEAD_DIM
IN_SPLITS = (W_A, W_A, W_A, W_A, W_B_QKV, W_B_QKV, W_B_QKV, W_B_OUT, W_M, W_M, N_BRANCH * D_MODEL)
IN_WIDTH = sum(IN_SPLITS)

kernel_name = "hybrid_moba_dilated_memory_gated"


def rms_norm(x, g):
    xf = x.astype(jnp.float32)
    y = xf * lax.rsqrt(jnp.mean(xf * xf, axis=-1, keepdims=True) + RMS_EPS)
    return (y * g.astype(jnp.float32)).astype(x.dtype)


def rope(x):
    S, D = x.shape[1], x.shape[-1]
    half = D // 2
    inv = ROPE_THETA ** (-jnp.arange(half, dtype=jnp.float32) / half)
    ang = jnp.arange(S, dtype=jnp.float32)[:, None] * inv[None, :]
    cos = jnp.cos(ang)[None, :, None, :]
    sin = jnp.sin(ang)[None, :, None, :]
    xf = x.astype(jnp.float32)
    x1, x2 = xf[..., :half], xf[..., half:]
    return jnp.concatenate([x1 * cos - x2 * sin, x2 * cos + x1 * sin], axis=-1).astype(x.dtype)


def moba_attention(q, k, v):
    B, S, H, D = q.shape
    C = MOBA_Q_CHUNK
    nb = -(-S // MOBA_BLOCK)
    s_pad = nb * MOBA_BLOCK
    scale = D ** -0.5
    qh = q.transpose(0, 2, 1, 3)
    pad = ((0, 0), (0, 0), (0, s_pad - S), (0, 0))
    kb = jnp.pad(k.transpose(0, 2, 1, 3), pad).reshape(B, H, nb, MOBA_BLOCK, D)
    vb = jnp.pad(v.transpose(0, 2, 1, 3), pad).reshape(B, H, nb, MOBA_BLOCK, D)
    k_mean = jnp.mean(kb.astype(jnp.float32), axis=3)
    gate = jnp.einsum('bhsd,bhnd->bhsn', qh.astype(jnp.float32), k_mean)
    q_blk = jnp.arange(S) // MOBA_BLOCK
    past = jnp.arange(nb)[None, :] < q_blk[:, None]
    gate = jnp.where(past[None, None], gate, -jnp.inf)
    n_sel = max(1, min(MOBA_TOPK, nb - 1))
    _, sel = lax.top_k(gate, n_sel)
    sel_valid = jnp.arange(n_sel)[None, :] < q_blk[:, None]

    nq = S // C
    qc = qh.reshape(B, H, nq, C, D).transpose(2, 0, 1, 3, 4)
    selc = sel.reshape(B, H, nq, C, n_sel).transpose(2, 0, 1, 3, 4)
    validc = sel_valid.reshape(nq, C, n_sel)
    bi = jnp.arange(B)[:, None, None, None]
    hi = jnp.arange(H)[None, :, None, None]

    def chunk(args):
        c, q_c, sel_c, valid_c = args
        start = c * C
        own = start // MOBA_BLOCK
        k_own = lax.dynamic_index_in_dim(kb, own, axis=2, keepdims=False)
        v_own = lax.dynamic_index_in_dim(vb, own, axis=2, keepdims=False)
        k_sel = kb[bi, hi, sel_c]
        v_sel = vb[bi, hi, sel_c]
        s_sel = jnp.einsum('bhqd,bhqnkd->bhqnk', q_c, k_sel,
                           preferred_element_type=jnp.float32) * scale
        s_sel = jnp.where(valid_c[None, None, :, :, None], s_sel, NEG)
        s_own = jnp.einsum('bhqd,bhkd->bhqk', q_c, k_own,
                           preferred_element_type=jnp.float32) * scale
        q_pos = start + jnp.arange(C)
        k_pos = own * MOBA_BLOCK + jnp.arange(MOBA_BLOCK)
        s_own = jnp.where(k_pos[None, :] <= q_pos[:, None], s_own, NEG)
        s_all = jnp.concatenate([s_sel.reshape(B, H, C, n_sel * MOBA_BLOCK), s_own], axis=-1)
        p = jax.nn.softmax(s_all, axis=-1)
        p_sel = p[..., :n_sel * MOBA_BLOCK].reshape(B, H, C, n_sel, MOBA_BLOCK).astype(v.dtype)
        p_own = p[..., n_sel * MOBA_BLOCK:].astype(v.dtype)
        return (jnp.einsum('bhqnk,bhqnkd->bhqd', p_sel, v_sel)
                + jnp.einsum('bhqk,bhkd->bhqd', p_own, v_own))

    out = lax.map(chunk, (jnp.arange(nq), qc, selc, validc))
    return out.transpose(1, 0, 3, 2, 4).reshape(B, S, H, D)


def dilated_group(q, k, v, window, dilation):
    B, S, H, D = q.shape
    band = window // dilation
    L = S // dilation
    nblk = -(-L // band)
    Lp = nblk * band
    scale = D ** -0.5

    def to_sub(t):
        t = t.reshape(B, L, dilation, H, D).transpose(0, 2, 3, 1, 4)
        t = jnp.pad(t, ((0, 0), (0, 0), (0, 0), (0, Lp - L), (0, 0)))
        return t.reshape(B, dilation, H, nblk, band, D)

    def with_prev(t):
        prev = jnp.concatenate([jnp.zeros_like(t[:, :, :, :1]), t[:, :, :, :-1]], axis=3)
        return jnp.concatenate([prev, t], axis=4)

    qs, ks, vs = to_sub(q), with_prev(to_sub(k)), with_prev(to_sub(v))
    s = jnp.einsum('brhnqd,brhnkd->brhnqk', qs, ks, preferred_element_type=jnp.float32) * scale
    n_i = jnp.arange(nblk)[:, None, None]
    q_i = jnp.arange(band)[None, :, None]
    k_i = jnp.arange(2 * band)[None, None, :] - band
    delta = q_i - k_i
    mask = (delta >= 0) & (delta <= band) & ((n_i > 0) | (k_i >= 0))
    s = jnp.where(mask, s, NEG)
    m = jnp.max(s, axis=-1, keepdims=True)
    p = jnp.exp(s - m)
    l = jnp.sum(p, axis=-1, keepdims=True)
    o = jnp.einsum('brhnqk,brhnkd->brhnqd', p, vs.astype(jnp.float32)) / l
    lse = (m + jnp.log(l))[..., 0]
    o = o.reshape(B, dilation, H, Lp, D)[:, :, :, :L].transpose(0, 3, 1, 2, 4).reshape(B, S, H, D)
    lse = lse.reshape(B, dilation, H, Lp)[:, :, :, :L].transpose(0, 3, 1, 2).reshape(B, S, H)
    return o, lse


def dilated_mixture(q, k, v):
    B, S, _, D = q.shape
    G = len(DIL_CONFIGS)
    qg = q.reshape(B, S, G, DIL_HEADS_PER_GROUP, D)
    kg = k.reshape(B, S, G, DIL_HEADS_PER_GROUP, D)
    vg = v.reshape(B, S, G, DIL_HEADS_PER_GROUP, D)
    outs, lses = [], []
    for g, (window, dilation) in enumerate(DIL_CONFIGS):
        o, lse = dilated_group(qg[:, :, g], kg[:, :, g], vg[:, :, g], window, dilation)
        outs.append(o)
        lses.append(lse)
    w = jax.nn.softmax(jnp.stack(lses, axis=0), axis=0)
    out = jnp.sum(w[..., None] * jnp.stack(outs, axis=0), axis=0)
    return out.astype(v.dtype)


def memory_attention(q, mk, mv):
    scale = q.shape[-1] ** -0.5
    s = jnp.einsum('bshd,bmhd->bhsm', q, mk, preferred_element_type=jnp.float32) * scale
    p = jax.nn.softmax(s, axis=-1).astype(mv.dtype)
    return jnp.einsum('bhsm,bmhd->bshd', p, mv)


def setup_inputs(seed: int = 0) -> dict:
    key = jax.random.key(seed)
    ks = jax.random.split(key, 11)
    f32 = jnp.float32
    x = jax.random.normal(ks[0], (BATCH, SEQ, D_MODEL), f32)
    mem = jax.random.normal(ks[1], (BATCH, MEM_LEN, D_MODEL), f32)
    norm_in_g = 1.0 + 0.05 * jax.random.normal(ks[2], (DEPTH, D_MODEL), f32)
    norm_mem_g = 1.0 + 0.05 * jax.random.normal(ks[3], (D_MODEL,), f32)
    w_in = jax.random.normal(ks[4], (DEPTH, D_MODEL, IN_WIDTH), f32) * D_MODEL ** -0.5
    w_mem_kv = jax.random.normal(ks[5], (DEPTH, D_MODEL, 2 * W_M), f32) * D_MODEL ** -0.5
    w_proj_a = jax.random.normal(ks[6], (DEPTH, W_A, D_MODEL), f32) * W_A ** -0.5
    w_proj_b = jax.random.normal(ks[7], (DEPTH, W_B_OUT, D_MODEL), f32) * W_B_OUT ** -0.5
    w_proj_m = jax.random.normal(ks[8], (DEPTH, W_M, D_MODEL), f32) * W_M ** -0.5
    w_out = jax.random.normal(ks[9], (DEPTH, D_MODEL, D_MODEL), f32) * D_MODEL ** -0.5
    norm_final_g = 1.0 + 0.05 * jax.random.normal(ks[10], (D_MODEL,), f32)
    return {"x": x, "mem": mem, "norm_in_g": norm_in_g, "norm_mem_g": norm_mem_g,
            "w_in": w_in, "w_mem_kv": w_mem_kv, "w_proj_a": w_proj_a, "w_proj_b": w_proj_b,
            "w_proj_m": w_proj_m, "w_out": w_out, "norm_final_g": norm_final_g}


def reference(x, mem, norm_in_g, norm_mem_g, w_in, w_mem_kv, w_proj_a, w_proj_b, w_proj_m,
              w_out, norm_final_g):
    B, S, _ = x.shape
    M = mem.shape[1]
    split_points = [int(p) for p in np.cumsum(IN_SPLITS)[:-1]]
    mem_n = rms_norm(mem, norm_mem_g)
    for layer in range(DEPTH):
        h = rms_norm(x, norm_in_g[layer])
        proj = jnp.einsum('bsd,de->bse', h, w_in[layer])
        (qa, ka, va, za, qb, kb, vb, zb, qm, zm, gates) = jnp.split(proj, split_points, axis=-1)

        qa = rope(qa.reshape(B, S, MOBA_HEADS, HEAD_DIM))
        ka = rope(ka.reshape(B, S, MOBA_HEADS, HEAD_DIM))
        va = va.reshape(B, S, MOBA_HEADS, HEAD_DIM)
        ya = moba_attention(qa, ka, va).reshape(B, S, W_A) * jax.nn.silu(za)

        hb = len(DIL_CONFIGS) * DIL_HEADS_PER_GROUP
        qb = rope(qb.reshape(B, S, hb, HEAD_DIM))
        kb = rope(kb.reshape(B, S, hb, HEAD_DIM))
        vb = vb.reshape(B, S, hb, HEAD_DIM)
        yb = dilated_mixture(qb, kb, vb).reshape(B, S, W_B_OUT) * jax.nn.silu(zb)

        mkv = jnp.einsum('bmd,de->bme', mem_n, w_mem_kv[layer])
        mk, mv = jnp.split(mkv, 2, axis=-1)
        ym = memory_attention(qm.reshape(B, S, MEM_HEADS, MEM_HEAD_DIM),
                              mk.reshape(B, M, MEM_HEADS, MEM_HEAD_DIM),
                              mv.reshape(B, M, MEM_HEADS, MEM_HEAD_DIM)).reshape(B, S, W_M)
        ym = ym * jax.nn.silu(zm)

        g_a, g_b, g_m = jnp.split(jax.nn.sigmoid(gates), N_BRANCH, axis=-1)
        merged = (g_a * jnp.einsum('bse,ed->bsd', ya, w_proj_a[layer])
                  + g_b * jnp.einsum('bse,ed->bsd', yb, w_proj_b[layer])
                  + g_m * jnp.einsum('bse,ed->bsd', ym, w_proj_m[layer]))
        x = x + jnp.einsum('bsd,de->bse', merged, w_out[layer])
    return rms_norm(x, norm_final_g)
```

```cpp
#include <hip/hip_runtime.h>
#include <hip/hip_cooperative_groups.h>
#include <cstdio>
#include <cstdint>
#include <cmath>
namespace cg = cooperative_groups;

#define LAS __attribute__((address_space(3)))
typedef unsigned short bf16_t;
typedef short bf16x8 __attribute__((ext_vector_type(8)));
typedef float f32x2 __attribute__((ext_vector_type(2)));
typedef float f32x4 __attribute__((ext_vector_type(4)));
typedef float f32x16 __attribute__((ext_vector_type(16)));
typedef unsigned u32x2 __attribute__((ext_vector_type(2)));
typedef unsigned u32x4 __attribute__((ext_vector_type(4)));
typedef __bf16 bf16x2_t __attribute__((ext_vector_type(2)));
typedef short v4i16_t __attribute__((ext_vector_type(4)));

constexpr int DM = 2048, NB = 8, SEQ = 2048, MTOK = NB * SEQ;
constexpr int MEML = 256, MROWS = NB * MEML;
constexpr int LDP = 11264;
constexpr int LDH = 2560;
constexpr int LDG = 6144;
constexpr int C_QA = 0, C_KA = 1024, C_VA = 2048, C_ZA = 3072, C_QB = 4096, C_KB = 5632, C_VB = 7168, C_ZB = 8704, C_QM = 9216, C_ZM = 10240;
constexpr float LOG2E = 1.4426950408889634f;
constexpr float QS128 = 0.08838834764831845f * LOG2E;
constexpr float QS256 = 0.0625f * LOG2E;
constexpr float NEGBIG = -1e30f;

constexpr size_t MiB = 1u << 20;
constexpr size_t WS_CTL = 0, WS_SSQ = 1 * MiB, WS_ROPE = 3 * MiB, WS_KMP = 4 * MiB, WS_LSE = 5 * MiB, WS_WOUT = 6 * MiB, WS_BTG = 14 * MiB,
                 WS_BT1 = 44 * MiB, WS_OB = 44 * MiB  , WS_H = 96 * MiB, WS_PROJ = 186 * MiB, WS_G = 186 * MiB  ,
                 WS_MERGED = 378 * MiB, WS_END = 538 * MiB;
constexpr size_t DO_Y = 0, DO_MKV = 80 * MiB, DO_WCAT = 88 * MiB;

__device__ __forceinline__ unsigned cvtpk(float lo, float hi) { f32x2 v = {lo, hi}; bf16x2_t b = __builtin_convertvector(v, bf16x2_t); return __builtin_bit_cast(unsigned, b); }
__device__ __forceinline__ float bflo(unsigned w) { return __uint_as_float(w << 16); }
__device__ __forceinline__ float bfhi(unsigned w) { return __uint_as_float(w & 0xffff0000u); }
__device__ __forceinline__ float wave_sum(float v) {
#pragma unroll
    for (int o = 1; o < 64; o <<= 1) v += __shfl_xor(v, o);
    return v;
}
__device__ __forceinline__ float fast_sigmoid(float v) { return __builtin_amdgcn_rcpf(1.0f + __builtin_amdgcn_exp2f(-v * LOG2E)); }
__device__ __forceinline__ float gate_sigmoid(float v) { return fast_sigmoid(fminf(fmaxf(v, -60.0f), 60.0f)); }

namespace pg8 {
constexpr int BM = 256, BK = 64, HALF = 128, HTB = HALF * BK * 2, STAGE_BYTES = 8 * HTB;
__host__ __device__ __forceinline__ int lds_byte(int r, int c) { const int st = (r >> 4) * 2 + (c >> 5), rr = r & 15, cc = c & 31, ob = rr * 64 + cc * 2; return st * 1024 + (ob ^ (((ob >> 9) & 1) << 5)); }
__host__ __device__ __forceinline__ void stage_rc(int b, int& R, int& C) { const int st = b / 1024, sb = b % 1024, swz = sb ^ (((sb >> 9) & 1) << 5); R = (st >> 1) * 16 + swz / 64; C = (st & 1) * 32 + (swz % 64) / 2; }
__host__ __device__ __forceinline__ int perm32(int rho) { const int n = rho >> 4, i = rho & 15; return 8 * (i >> 2) + 4 * n + (i & 3); }

struct Unit { const char* a; const char* b; int nt; int kind; int pm; int pn; };
template <class Sched, class Epi>
__device__ __forceinline__ void gemm_phase(LAS unsigned char* lds, const int ldA, const int ldB, const Sched& S, const Epi& E) {
    int tid_ = threadIdx.x; asm volatile("" : "+v"(tid_));
    const int tid = tid_, wid = __builtin_amdgcn_readfirstlane(tid >> 6), lane = tid & 63, wr = wid >> 2, wc = wid & 3, fr = lane & 15, fq = lane >> 4;
    unsigned voffA[2], voffB[2];
#pragma unroll
    for (int i = 0; i < 2; ++i) { int R, C; stage_rc(tid * 16 + i * 8192, R, C); const int Rb = (R & ~31) + perm32(R & 31);
        voffA[i] = (unsigned)(R * ldA + C) * 2u; voffB[i] = (unsigned)(Rb * ldB + C) * 2u; }
    const size_t kstep = (size_t)(BK * 2);
    const size_t hstepA = (size_t)HALF * ldA * 2, hstepB = (size_t)HALF * ldB * 2;
    const unsigned ldsw = (unsigned)wid * 1024u;
    const int aoff = lds_byte(wr * 64 + fr, fq * 8), boff = lds_byte(wc * 32 + fr, fq * 8);
#define PG8_SA(b, h) (((b) * 2 + (h)) * HTB)
#define PG8_SB(b, h) ((4 + (b) * 2 + (h)) * HTB)
#define PG8_STAGE(bufoff, gbase, voff) do { _Pragma("unroll") for (int _i = 0; _i < 2; ++_i) \
        __builtin_amdgcn_global_load_lds((const unsigned*)((const char*)(gbase) + (voff)[_i]), (LAS unsigned*)(lds + (bufoff) + ldsw + _i * 8192), 16, 0, 0); } while (0)
#define PG8_LDA(dst, b, h) do { _Pragma("unroll") for (int m = 0; m < 4; ++m) _Pragma("unroll") for (int k = 0; k < 2; ++k) dst[m][k] = *(const LAS bf16x8*)(lds + PG8_SA(b, h) + aoff + m * 2048 + k * 1024); } while (0)
#define PG8_LDB(dst, b, h) do { _Pragma("unroll") for (int n = 0; n < 2; ++n) _Pragma("unroll") for (int k = 0; k < 2; ++k) dst[n][k] = *(const LAS bf16x8*)(lds + PG8_SB(b, h) + boff + n * 2048 + k * 1024); } while (0)
#define PG8_MMA(ai, bj, At, Bt) do { __builtin_amdgcn_s_setprio(1); _Pragma("unroll") for (int m = 0; m < 4; ++m) _Pragma("unroll") for (int n = 0; n < 2; ++n) _Pragma("unroll") for (int k = 0; k < 2; ++k) \
        acc[ai][bj][m][n] = __builtin_amdgcn_mfma_f32_16x16x32_bf16(Bt[n][k], At[m][k], acc[ai][bj][m][n], 0, 0, 0); __builtin_amdgcn_s_setprio(0); } while (0)
#define PG8_WAIT_V(n) asm volatile("s_waitcnt vmcnt(" #n ")" ::: "memory")
#define PG8_WAIT_L(n) asm volatile("s_waitcnt lgkmcnt(" #n ")" ::: "memory")
#define PG8_BAR __builtin_amdgcn_s_barrier()
#define PG8_SCHED __builtin_amdgcn_sched_barrier(0)
    Unit cur, nxt; int ui = 0;
    if (!S.next(0, cur)) return;
    f32x4 acc[2][2][4][2];
#pragma unroll
    for (int a = 0; a < 2; ++a)
#pragma unroll
        for (int b = 0; b < 2; ++b)
#pragma unroll
            for (int m = 0; m < 4; ++m)
#pragma unroll
                for (int n = 0; n < 2; ++n) acc[a][b][m][n] = (f32x4){0.f, 0.f, 0.f, 0.f};
    bf16x8 At[4][2], B0[2][2], B1[2][2];
    const char* cA = cur.a; const char* cB = cur.b;
    PG8_STAGE(PG8_SB(0, 0), cB, voffB); PG8_STAGE(PG8_SB(0, 1), cB + hstepB, voffB); PG8_STAGE(PG8_SA(0, 0), cA, voffA); PG8_STAGE(PG8_SA(0, 1), cA + hstepA, voffA);
    if (wr == 1) PG8_BAR;
    PG8_WAIT_V(2); PG8_BAR;
    PG8_STAGE(PG8_SB(1, 0), cB + kstep, voffB); PG8_STAGE(PG8_SA(1, 0), cA + kstep, voffA); PG8_STAGE(PG8_SB(1, 1), cB + hstepB + kstep, voffB);
    PG8_WAIT_V(6); PG8_BAR;
    for (;;) {
        const bool has_next = S.next(ui + 1, nxt);
        const char* nA = has_next ? nxt.a : cA; const char* nB = has_next ? nxt.b : cB;
        const int nt = cur.nt;
        for (int t = 0; t < nt; t += 2) {
            if constexpr (Epi::HOOK) E.hook(acc, cur, t, wr, wc, fr, fq);
            const bool last = (t == nt - 2);
            const char* a1 = cA + (size_t)(t + 1) * kstep;
            const char* a2 = last ? nA : cA + (size_t)(t + 2) * kstep; const char* b2 = last ? nB : cB + (size_t)(t + 2) * kstep;
            const char* a3 = a2 + kstep; const char* b3 = b2 + kstep;
            PG8_LDB(B0, 0, 0); PG8_LDB(B1, 0, 1); PG8_SCHED; PG8_LDA(At, 0, 0); PG8_STAGE(PG8_SA(1, 1), a1 + hstepA, voffA);
            PG8_WAIT_V(8); PG8_WAIT_L(0); PG8_BAR; PG8_MMA(0, 0, At, B0); PG8_MMA(0, 1, At, B1); PG8_BAR; PG8_SCHED;
            PG8_LDA(At, 0, 1); PG8_STAGE(PG8_SB(0, 0), b2, voffB); PG8_STAGE(PG8_SB(0, 1), b2 + hstepB, voffB); PG8_STAGE(PG8_SA(0, 0), a2, voffA);
            PG8_WAIT_V(8); PG8_WAIT_L(0); PG8_BAR; PG8_MMA(1, 0, At, B0); PG8_MMA(1, 1, At, B1); PG8_BAR; PG8_SCHED;
            PG8_LDB(B0, 1, 0); PG8_LDB(B1, 1, 1); PG8_SCHED; PG8_LDA(At, 1, 0); PG8_STAGE(PG8_SA(0, 1), a2 + hstepA, voffA);
            PG8_WAIT_V(8); PG8_WAIT_L(0); PG8_BAR; PG8_MMA(0, 0, At, B0); PG8_MMA(0, 1, At, B1); PG8_BAR; PG8_SCHED;
            PG8_LDA(At, 1, 1); PG8_STAGE(PG8_SB(1, 0), b3, voffB); PG8_STAGE(PG8_SB(1, 1), b3 + hstepB, voffB); PG8_STAGE(PG8_SA(1, 0), a3, voffA);
            PG8_WAIT_V(8); PG8_WAIT_L(0); PG8_BAR; PG8_MMA(1, 0, At, B0); PG8_MMA(1, 1, At, B1); PG8_BAR; PG8_SCHED;
        }
        if (wr == 0) PG8_BAR;
        E(acc, cur, wr, wc, fr, fq);
        if (!has_next) break;
#pragma unroll
        for (int a = 0; a < 2; ++a)
#pragma unroll
            for (int b = 0; b < 2; ++b)
#pragma unroll
                for (int m = 0; m < 4; ++m)
#pragma unroll
                    for (int n = 0; n < 2; ++n) acc[a][b][m][n] = (f32x4){0.f, 0.f, 0.f, 0.f};
        cur = nxt; cA = nA; cB = nB; ++ui;
        if (wr == 1) PG8_BAR;
    }
    PG8_WAIT_V(0);
    PG8_BAR;
#undef PG8_SA
#undef PG8_SB
#undef PG8_STAGE
#undef PG8_LDA
#undef PG8_LDB
#undef PG8_MMA
#undef PG8_WAIT_V
#undef PG8_WAIT_L
#undef PG8_BAR
#undef PG8_SCHED
}
}
using pg8::Unit;
typedef f32x4 Acc[2][2][4][2];

struct Sched1 {
    const char* H; const char* BT1; int G, c;
    __device__ __forceinline__ bool next(int i, Unit& u) const {
        const int L = i * G + c; constexpr int nM = 64, nN = 44, nwg = nM * nN;
        if (L >= nwg) return false;
        int wgid = L; { const int q = nwg / 8, r = nwg % 8, xcd = wgid % 8, off = wgid / 8; wgid = (xcd < r ? xcd * (q + 1) : r * (q + 1) + (xcd - r) * q) + off; }
        const int nig = 8 * nN, gid = wgid / nig, fm = gid * 8, gsz = (nM - fm) < 8 ? (nM - fm) : 8;
        const int pm = fm + ((wgid % nig) % gsz), pn = (wgid % nig) / gsz;
        u.pm = pm; u.pn = pn; u.nt = 32; u.kind = 0;
        u.a = H + (size_t)pm * 256 * LDH * 2; u.b = BT1 + (size_t)pn * 256 * DM * 2;
        return true;
    }
};
struct Sched1m {
    const char* H; const char* BT1; int e;
    __device__ __forceinline__ bool next(int i, Unit& u) const {
        if (i > 0 || e >= 64) return false;
        const int pm = 64 + (e & 7), pn = 44 + (e >> 3);
        u.pm = pm; u.pn = pn; u.nt = 32; u.kind = 0;
        u.a = H + (size_t)pm * 256 * LDH * 2; u.b = BT1 + (size_t)pn * 256 * DM * 2;
        return true;
    }
};
struct Epi1 {
    static constexpr bool HOOK = false;
    bf16_t* proj; bf16_t* mkv; float* kmp; const float* rope;
    __device__ __forceinline__ void hook(Acc&, const Unit&, int, int, int, int, int) const {}
    __device__ __forceinline__ void operator()(const Acc& acc, const Unit& u, int wr, int wc, int fr, int fq) const {
        const int pn = u.pn, pm = u.pm;
        int kind = 0, sh = 0; float sc = 1.f; bool kmean = false; bf16_t* base = proj; int ldc = LDP; int colt = pn * 256; int rowt = pm * 256;
        if (pm >= 64) { base = mkv; ldc = 2048; colt = (pn - 44) * 256; rowt = (pm - 64) * 256; }
        else if (pn < 4) { kind = 1; sc = QS128; }
        else if (pn < 8) { kind = 1; kmean = true; }
        else if (pn < 12) { kind = 0; }
        else if (pn < 16) { kind = 2; }
        else if (pn < 22) { kind = 1; sc = QS128; sh = 2 * ((pn - 16) >> 1); }
        else if (pn < 28) { kind = 1; sh = 2 * ((pn - 22) >> 1); }
        else if (pn < 34) { kind = 0; sh = 2 * ((pn - 28) >> 1); }
        else if (pn < 36) { kind = 2; }
        else if (pn < 40) { kind = 0; sc = QS256; }
        else { kind = 2; }
        const int sh_ = sh; const int ldc_ = ldc;
#define EPI1_STORE(ai, m, V00, V01, V10, V11) do { \
            int row = rowt + (ai) * 128 + wr * 64 + (m) * 16 + fr; \
            if (sh_) { const int b_ = row >> 11, p_ = row & 2047; row = (b_ << 11) + ((p_ & ((1 << sh_) - 1)) << (11 - sh_)) + (p_ >> sh_); } \
            bf16_t* rowp = base + (size_t)row * ldc_ + colt + wc * 32 + fq * 8; \
            u32x4 w_; w_.x = cvtpk(V00[0], V00[1]); w_.y = cvtpk(V00[2], V00[3]); w_.z = cvtpk(V01[0], V01[1]); w_.w = cvtpk(V01[2], V01[3]); __builtin_nontemporal_store(w_, (u32x4*)(rowp)); \
            w_.x = cvtpk(V10[0], V10[1]); w_.y = cvtpk(V10[2], V10[3]); w_.z = cvtpk(V11[0], V11[1]); w_.w = cvtpk(V11[2], V11[3]); __builtin_nontemporal_store(w_, (u32x4*)(rowp + 128)); } while (0)
        if (kind == 1) {
            f32x4 ksum[2][2];
#pragma unroll
            for (int bj = 0; bj < 2; ++bj)
#pragma unroll
                for (int n = 0; n < 2; ++n) ksum[bj][n] = (f32x4){0.f, 0.f, 0.f, 0.f};
            const int pos0 = (rowt + wr * 64 + fr) & (SEQ - 1), fo = (16 * wc + 4 * fq) * 2;
            const f32x4* rp0 = (const f32x4*)(rope + (size_t)pos0 * 128 + fo); const f32x4* rp16 = (const f32x4*)(rope + (size_t)16 * 128 + fo); const f32x4* rp128 = (const f32x4*)(rope + (size_t)128 * 128 + fo);
            const f32x4 a0 = rp0[0], a1 = rp0[1], b0 = rp16[0], b1 = rp16[1], d0 = rp128[0], d1 = rp128[1];
            const f32x4 c16 = {b0[0], b0[2], b1[0], b1[2]}, s16 = {b0[1], b0[3], b1[1], b1[3]}, c128 = {d0[0], d0[2], d1[0], d1[2]}, s128 = {d0[1], d0[3], d1[1], d1[3]};
            f32x4 cb = {a0[0], a0[2], a1[0], a1[2]}, sb = {a0[1], a0[3], a1[1], a1[3]};
#pragma unroll
            for (int ai = 0; ai < 2; ++ai) {
                f32x4 cs = cb, sn = sb;
#pragma unroll
                for (int m = 0; m < 4; ++m) {
                    f32x4 o[2][2];
#pragma unroll
                    for (int bj = 0; bj < 2; ++bj) {
                        const f32x4 x1 = acc[ai][bj][m][0], x2 = acc[ai][bj][m][1];
                        o[bj][0] = (x1 * cs - x2 * sn) * sc; o[bj][1] = (x2 * cs + x1 * sn) * sc;
                        ksum[bj][0] += o[bj][0]; ksum[bj][1] += o[bj][1];
                    }
                    EPI1_STORE(ai, m, o[0][0], o[0][1], o[1][0], o[1][1]);
                    const f32x4 cn = cs * c16 - sn * s16, sn2 = sn * c16 + cs * s16; cs = cn; sn = sn2;
                }
                const f32x4 cn = cb * c128 - sb * s128, sn2 = sb * c128 + cb * s128; cb = cn; sb = sn2;
            }
            if (kmean) {
#pragma unroll
                for (int bj = 0; bj < 2; ++bj)
#pragma unroll
                    for (int n = 0; n < 2; ++n) {
                        f32x4 s = ksum[bj][n];
#pragma unroll
                        for (int j = 0; j < 4; ++j) { float v = s[j]; v += __shfl_xor(v, 1); v += __shfl_xor(v, 2); v += __shfl_xor(v, 4); v += __shfl_xor(v, 8); s[j] = v; }
                        if (fr == 0) *(f32x4*)(kmp + ((size_t)pm * 2 + wr) * 1024 + (pn - 4) * 256 + bj * 128 + wc * 32 + fq * 8 + n * 4) = s;
                    }
            }
        } else if (kind == 2) {
#pragma unroll
            for (int ai = 0; ai < 2; ++ai)
#pragma unroll
                for (int m = 0; m < 4; ++m) {
                    f32x4 o[2][2];
#pragma unroll
                    for (int bj = 0; bj < 2; ++bj)
#pragma unroll
                        for (int n = 0; n < 2; ++n)
#pragma unroll
                            for (int j = 0; j < 4; ++j) { const float v = acc[ai][bj][m][n][j]; o[bj][n][j] = v * fast_sigmoid(v); }
                    EPI1_STORE(ai, m, o[0][0], o[0][1], o[1][0], o[1][1]);
                    asm volatile("" ::: "memory");
                }
        } else {
#pragma unroll
            for (int ai = 0; ai < 2; ++ai)
#pragma unroll
                for (int m = 0; m < 4; ++m) {
                    f32x4 o[2][2];
#pragma unroll
                    for (int bj = 0; bj < 2; ++bj)
#pragma unroll
                        for (int n = 0; n < 2; ++n) o[bj][n] = acc[ai][bj][m][n] * sc;
                    EPI1_STORE(ai, m, o[0][0], o[0][1], o[1][0], o[1][1]);
                    asm volatile("" ::: "memory");
                }
        }
#undef EPI1_STORE
    }
};

struct Sched3 {
    const char* H; const char* BTG; const char* Y; const char* WCAT; int G, vcu;
    __device__ __forceinline__ bool next(int i, Unit& u) const {
        const int k = i >> 2, s = i & 3, T = vcu + G * k;
        if (T >= 512) return false;
        const int pm = T >> 3, pn = T & 7;
        u.pm = pm; u.pn = pn; u.kind = s;
        if (s < 3) { u.nt = 32; u.a = H + (size_t)pm * 256 * LDH * 2; u.b = BTG + (size_t)(s * 2048 + pn * 256) * LDH * 2; }
        else { u.nt = 40; u.a = Y + (size_t)pm * 256 * LDH * 2; u.b = WCAT + (size_t)pn * 256 * LDH * 2; }
        return true;
    }
};
struct Epi3 {
    static constexpr bool HOOK = true;
    bf16_t* Gb; bf16_t* merged;
    __device__ __forceinline__ void hook(Acc& acc, const Unit& u, int t, int wr, int wc, int fr, int fq) const {
        if (u.kind != 3 || (t != 16 && t != 24)) return;
        const int from = (t == 16) ? 0 : 1;
        const bf16_t* gp = Gb + (size_t)(u.pm * 256 + wr * 64 + fr) * LDG + from * 2048 + u.pn * 256 + wc * 32 + fq * 8;
        u32x4 A[2][2], B[2][2];
        A[0][0] = *(const u32x4*)(gp); A[0][1] = *(const u32x4*)(gp + 128); B[0][0] = *(const u32x4*)(gp + 2048); B[0][1] = *(const u32x4*)(gp + 128 + 2048);
#pragma unroll
        for (int it = 0; it < 8; ++it) {
            const int ai = it >> 2, m = it & 3, cur = it & 1, nxt = cur ^ 1;
            gp += (m == 3 ? 80 : 16) * LDG;
            asm volatile("" : "+v"(gp) :: "memory");
            if (it < 7) { A[nxt][0] = *(const u32x4*)(gp); A[nxt][1] = *(const u32x4*)(gp + 128); B[nxt][0] = *(const u32x4*)(gp + 2048); B[nxt][1] = *(const u32x4*)(gp + 128 + 2048); }
#pragma unroll
            for (int bj = 0; bj < 2; ++bj) {
                const u32x4 a = A[cur][bj], b = B[cur][bj];
                f32x4 f0, f1;
                f0[0] = bflo(a.x) * __builtin_amdgcn_rcpf(bflo(b.x)); f0[1] = bfhi(a.x) * __builtin_amdgcn_rcpf(bfhi(b.x));
                f0[2] = bflo(a.y) * __builtin_amdgcn_rcpf(bflo(b.y)); f0[3] = bfhi(a.y) * __builtin_amdgcn_rcpf(bfhi(b.y));
                f1[0] = bflo(a.z) * __builtin_amdgcn_rcpf(bflo(b.z)); f1[1] = bfhi(a.z) * __builtin_amdgcn_rcpf(bfhi(b.z));
                f1[2] = bflo(a.w) * __builtin_amdgcn_rcpf(bflo(b.w)); f1[3] = bfhi(a.w) * __builtin_amdgcn_rcpf(bfhi(b.w));
                acc[ai][bj][m][0] *= f0; acc[ai][bj][m][1] *= f1;
            }
        }
    }
    __device__ __forceinline__ void operator()(const Acc& acc, const Unit& u, int wr, int wc, int fr, int fq) const {
        if (u.kind < 3) {
            bf16_t* gp = Gb + (size_t)(u.pm * 256 + wr * 64 + fr) * LDG + u.kind * 2048 + u.pn * 256 + wc * 32 + fq * 8;
#pragma unroll
            for (int ai = 0; ai < 2; ++ai)
#pragma unroll
                for (int m = 0; m < 4; ++m) {
                    asm volatile("" : "+v"(gp) :: "memory");
#pragma unroll
                    for (int bj = 0; bj < 2; ++bj) { const f32x4 v0 = acc[ai][bj][m][0], v1 = acc[ai][bj][m][1];
                        u32x4 w; w.x = cvtpk(gate_sigmoid(v0[0]), gate_sigmoid(v0[1])); w.y = cvtpk(gate_sigmoid(v0[2]), gate_sigmoid(v0[3]));
                        w.z = cvtpk(gate_sigmoid(v1[0]), gate_sigmoid(v1[1])); w.w = cvtpk(gate_sigmoid(v1[2]), gate_sigmoid(v1[3]));
                        *(u32x4*)(gp + bj * 128) = w; }
                    gp += (m == 3 ? 80 : 16) * LDG;
                }
        } else {
            const bf16_t* gp = Gb + (size_t)(u.pm * 256 + wr * 64 + fr) * LDG + 2 * 2048 + u.pn * 256 + wc * 32 + fq * 8;
            bf16_t* op = merged + (size_t)(u.pm * 256 + wr * 64 + fr) * DM + u.pn * 256 + wc * 32 + fq * 8;
            u32x4 Gv[2][2];
            Gv[0][0] = *(const u32x4*)(gp); Gv[0][1] = *(const u32x4*)(gp + 128);
#pragma unroll
            for (int it = 0; it < 8; ++it) {
                const int ai = it >> 2, m = it & 3, cur = it & 1, nxt = cur ^ 1;
                gp += (m == 3 ? 80 : 16) * LDG;
                asm volatile("" : "+v"(gp), "+v"(op) :: "memory");
                if (it < 7) { Gv[nxt][0] = *(const u32x4*)(gp); Gv[nxt][1] = *(const u32x4*)(gp + 128); }
#pragma unroll
                for (int bj = 0; bj < 2; ++bj) { const u32x4 g = Gv[cur][bj]; const f32x4 v0 = acc[ai][bj][m][0], v1 = acc[ai][bj][m][1];
                    u32x4 w; w.x = cvtpk(v0[0] * bflo(g.x), v0[1] * bfhi(g.x)); w.y = cvtpk(v0[2] * bflo(g.y), v0[3] * bfhi(g.y));
                    w.z = cvtpk(v1[0] * bflo(g.z), v1[1] * bfhi(g.z)); w.w = cvtpk(v1[2] * bflo(g.w), v1[3] * bfhi(g.w));
                    *(u32x4*)(op + bj * 128) = w; }
                op += (m == 3 ? 80 : 16) * DM;
            }
        }
    }
};

struct Sched4 {
    const char* A; const char* B; int G, vcu;
    __device__ __forceinline__ bool next(int i, Unit& u) const {
        const int T = vcu + G * i; if (T >= 512) return false;
        u.pm = T >> 3; u.pn = T & 7; u.nt = 32; u.kind = 0;
        u.a = A + (size_t)u.pm * 256 * DM * 2; u.b = B + (size_t)u.pn * 256 * DM * 2; return true;
    }
};
struct Epi4 {
    static constexpr bool HOOK = false;
    const float* x; float* out; float* ssq; unsigned* pcnt; const float* gfin;
    __device__ __forceinline__ void hook(Acc&, const Unit&, int, int, int, int, int) const {}
    __device__ __forceinline__ void operator()(Acc& acc, const Unit& u, int wr, int wc, int fr, int fq) const {
        const size_t off0 = (size_t)(u.pm * 256 + wr * 64 + fr) * DM + u.pn * 256 + wc * 32 + fq * 8;
        const float* xp = x + off0;
        float* sp = ssq + u.pm * 256 + wr * 64 + fr;
        f32x4 X[2][2][2];
#pragma unroll
        for (int bj = 0; bj < 2; ++bj)
#pragma unroll
            for (int n = 0; n < 2; ++n) X[0][bj][n] = *(const f32x4*)(xp + bj * 128 + n * 4);
#pragma unroll
        for (int it = 0; it < 8; ++it) {
            const int ai = it >> 2, m = it & 3, cur = it & 1, nxt = cur ^ 1;
            xp += (m == 3 ? 80 : 16) * DM;
            asm volatile("" : "+v"(xp) :: "memory");
            if (it < 7) {
#pragma unroll
                for (int bj = 0; bj < 2; ++bj)
#pragma unroll
                    for (int n = 0; n < 2; ++n) X[nxt][bj][n] = *(const f32x4*)(xp + bj * 128 + n * 4);
            }
            float s = 0.f;
#pragma unroll
            for (int bj = 0; bj < 2; ++bj)
#pragma unroll
                for (int n = 0; n < 2; ++n) {
                    const f32x4 o = X[cur][bj][n] + acc[ai][bj][m][n];
                    acc[ai][bj][m][n] = o;
                    s += (o[0] * o[0] + o[1] * o[1]) + (o[2] * o[2] + o[3] * o[3]);
                }
            s += __shfl_xor(s, 16); s += __shfl_xor(s, 32);
            if (fq == 0) (void)__hip_atomic_fetch_add(sp + ai * 128 + m * 16, s, __ATOMIC_RELAXED, __HIP_MEMORY_SCOPE_AGENT);
        }
        asm volatile("s_waitcnt vmcnt(0)" ::: "memory");
        unsigned* pc = pcnt + 64 * u.pm;
        if (fq == 0 && fr == 0) (void)__hip_atomic_fetch_add(pc, 1u, __ATOMIC_RELAXED, __HIP_MEMORY_SCOPE_AGENT);
        float* op = out + off0;
        const float* gp = gfin + u.pn * 256 + wc * 32 + fq * 8;
        f32x4 gv[2][2];
#pragma unroll
        for (int bj = 0; bj < 2; ++bj)
#pragma unroll
            for (int n = 0; n < 2; ++n) gv[bj][n] = *(const f32x4*)(gp + bj * 128 + n * 4);
        { unsigned spin = 0; while (__hip_atomic_load(pc, __ATOMIC_RELAXED, __HIP_MEMORY_SCOPE_AGENT) < 64u) { __builtin_amdgcn_s_sleep(1); if (++spin > (1u << 20)) break; } }
        asm volatile("" ::: "memory");
        float tot[8];
#pragma unroll
        for (int it = 0; it < 8; ++it) tot[it] = __hip_atomic_load(sp + (it >> 2) * 128 + (it & 3) * 16, __ATOMIC_RELAXED, __HIP_MEMORY_SCOPE_AGENT);
#pragma unroll
        for (int it = 0; it < 8; ++it) {
            const int ai = it >> 2, m = it & 3;
            const float rs = 1.0f / sqrtf(tot[it] * (1.0f / DM) + 1e-6f);
#pragma unroll
            for (int bj = 0; bj < 2; ++bj)
#pragma unroll
                for (int n = 0; n < 2; ++n) *(f32x4*)(op + bj * 128 + n * 4) = acc[ai][bj][m][n] * rs * gv[bj][n];
            op += (m == 3 ? 80 : 16) * DM;
            asm volatile("" : "+v"(op));
        }
    }
};

struct AttnC { const bf16_t* proj; const bf16_t* mkv; const float* kmp; bf16_t* Y; bf16_t* OB; float* LSE; };
__device__ __forceinline__ int crow(int r, int hi) { return (r & 3) + 8 * (r >> 2) + 4 * hi; }

template <int DQK, int MODE>
__device__ __forceinline__ void attn_unit(LAS unsigned char* lds, const AttnC& C, const int p0, const int p1, const int p2, const int p3) {
    int tid_ = threadIdx.x; asm volatile("" : "+v"(tid_));
    const int tid = tid_, lane = tid & 63, wid = __builtin_amdgcn_readfirstlane(tid >> 6), r32 = lane & 31, hi = lane >> 5;
    constexpr int KP = DQK * 2 + 16, NQ = DQK / 16, KCH = DQK / 8, KPT = 64 * KCH / 512;
    LAS unsigned char* Ks = lds; LAS unsigned char* Vt = lds + 36864; LAS float* km = (LAS float*)(lds + 131072);
    const bf16_t *Qb, *Kb, *Vb; int ldk, NT, t0 = 0;
    if (MODE == 0) { const size_t rb = (size_t)p0 * SEQ; Qb = C.proj + (rb + p2 * 256) * LDP + C_QA + p1 * 128; Kb = C.proj + rb * LDP + C_KA + p1 * 128; Vb = C.proj + rb * LDP + C_VA + p1 * 128; ldk = LDP; NT = 4 * (p2 + 1); }
    else if (MODE == 1) { const size_t rb = (size_t)p1 * SEQ; const int hd = 4 * p0 + p2; Qb = C.proj + (rb + p3 * 256) * LDP + C_QB + hd * 128; Kb = C.proj + rb * LDP + C_KB + hd * 128; Vb = C.proj + rb * LDP + C_VB + hd * 128;
        ldk = LDP; { const int lg = 11 - 2 * p0, rs = ((256 * p3) >> lg) << (lg - 6); t0 = (4 * p3 - 2) > rs ? (4 * p3 - 2) : rs; }
        NT = 4 * p3 + 4 - t0; }
    else { Qb = C.proj + ((size_t)p0 * SEQ + p2 * 256) * LDP + C_QM + p1 * 256; Kb = C.mkv + (size_t)p0 * MEML * 2048 + p1 * 256; Vb = C.mkv + (size_t)p0 * MEML * 2048 + 1024 + p1 * 256 + p3 * 128; ldk = 2048; NT = 4; }
    bf16x8 qr[NQ];
    { const bf16_t* qrow = Qb + (size_t)(32 * wid + r32) * LDP + 8 * hi;
#pragma unroll
      for (int d0 = 0; d0 < NQ; ++d0) qr[d0] = *(const bf16x8*)(qrow + 16 * d0); }
    LAS unsigned char* const stg = lds + 65536 + wid * 8192;
    if (MODE != 1) {
        const size_t tokz = (size_t)p0 * SEQ + p2 * 256 + 32 * wid;
        const bf16_t* zsrc = (MODE == 0) ? C.proj + tokz * LDP + C_ZA + p1 * 128 : C.proj + tokz * LDP + C_ZM + p1 * 256 + p3 * 128;
#pragma unroll
        for (int i = 0; i < 8; ++i) { const int row = 4 * i + (lane >> 4), ch = (lane & 15) ^ (row & 15);
            __builtin_amdgcn_global_load_lds((const unsigned*)(zsrc + (size_t)row * LDP + ch * 8), (LAS unsigned*)(stg + i * 1024), 16, 0, 0); }
    }
    u32x4 kreg[KPT], vreg0, vreg1;
    const int vpr = ((wid >> 1) << 3) + (lane >> 3), vdc = ((wid & 1) << 3) + (lane & 7);
    auto krow = [&](int t) -> int { if (MODE == 0) return t < 4 ? p2 * 256 + 64 * t : 64 * (t - 4); else return 64 * (t0 + t); };
    auto load_tile = [&](int t) {
        const size_t r0 = (size_t)krow(t);
#pragma unroll
        for (int i = 0; i < KPT; ++i) { const int c = tid + 512 * i, row = c / KCH, ch = c % KCH; kreg[i] = *(const u32x4*)(Kb + (r0 + row) * ldk + ch * 8); }
        vreg0 = *(const u32x4*)(Vb + (r0 + 2 * vpr) * ldk + vdc * 8); vreg1 = *(const u32x4*)(Vb + (r0 + 2 * vpr + 1) * ldk + vdc * 8);
    };
    constexpr bool PREF = false;
    auto dma_tile = [&](int t, int buf) {
        const size_t r0 = (size_t)krow(t);
#pragma unroll
        for (int i = 0; i < 2; ++i) {
            const int j = 2 * wid + i, row = 4 * j + (lane >> 4), pos = lane & 15;
            const int chk = pos ^ (row & 15), chv = pos ^ (((row & 3) << 2) | ((row >> 2) & 3));
            __builtin_amdgcn_global_load_lds((const unsigned*)(Kb + (r0 + row) * ldk + chk * 8), (LAS unsigned*)(lds + buf * 16384 + j * 1024), 16, 0, 0);
            __builtin_amdgcn_global_load_lds((const unsigned*)(Vb + (r0 + row) * ldk + chv * 8), (LAS unsigned*)(lds + 32768 + buf * 16384 + j * 1024), 16, 0, 0);
        }
    };
    if (DQK == 128) dma_tile(0, 0);
    unsigned sel = 0;
    if (MODE == 0) {
        const int qb = p2;
        if (qb > 3) for (int e = tid; e < qb * 128; e += 512) { const int n = e >> 7, d = e & 127; const float* kp = C.kmp + ((size_t)(p0 * 8 + n) * 2) * 1024 + p1 * 128 + d; km[e] = (kp[0] + kp[1024]) * (1.0f / 256.0f); }
        if (qb > 3) __syncthreads();
        if (qb <= 3) sel = (1u << qb) - 1u;
        else {
            float v1 = -INFINITY, v2 = -INFINITY, v3 = -INFINITY; int i1 = 0, i2 = 0, i3 = 0;
#pragma unroll 1
            for (int n = 0; n < qb; ++n) {
                float s = 0.f;
#pragma unroll
                for (int d0 = 0; d0 < NQ; ++d0) {
                    const f32x4 k0 = *(const LAS f32x4*)(km + n * 128 + 16 * d0 + 8 * hi), k1 = *(const LAS f32x4*)(km + n * 128 + 16 * d0 + 8 * hi + 4);
                    const u32x4 qw = __builtin_bit_cast(u32x4, qr[d0]);
                    s += bflo(qw.x) * k0[0] + bfhi(qw.x) * k0[1] + bflo(qw.y) * k0[2] + bfhi(qw.y) * k0[3] + bflo(qw.z) * k1[0] + bfhi(qw.z) * k1[1] + bflo(qw.w) * k1[2] + bfhi(qw.w) * k1[3];
                }
                { auto rr = __builtin_amdgcn_permlane32_swap(__float_as_uint(s), __float_as_uint(s), false, false); s = __uint_as_float(rr[0]) + __uint_as_float(rr[1]); }
                const bool g1 = s > v1, g2 = s > v2, g3 = s > v3;
                v3 = g2 ? v2 : (g3 ? s : v3); i3 = g2 ? i2 : (g3 ? n : i3);
                v2 = g1 ? v1 : (g2 ? s : v2); i2 = g1 ? i1 : (g2 ? n : i2);
                v1 = g1 ? s : v1; i1 = g1 ? n : i1;
            }
            sel = (1u << i1) | (1u << i2) | (1u << i3);
        }
    }
    const int lgL = (MODE == 1) ? (11 - 2 * p0) : 0;
    float m_run = NEGBIG, l_run = 0.f;
    f32x16 o[4];
#pragma unroll
    for (int i = 0; i < 4; ++i)
#pragma unroll
        for (int r = 0; r < 16; ++r) o[i][r] = 0.f;
    const int qpos = 32 * wid + r32;
    if constexpr (DQK == 128) {
    for (int t = 0; t < NT; ++t) {
        asm volatile("s_waitcnt vmcnt(0)" ::: "memory");
        __syncthreads();
        if (t + 1 < NT) dma_tile(t + 1, (t + 1) & 1);
        LAS unsigned char* const Kt = lds + (t & 1) * 16384; LAS unsigned char* const Vi = lds + 32768 + (t & 1) * 16384;
        bool skip = false; bool lanevalid = true;
        if (MODE == 0) { if (t < 4) skip = (64 * t > 32 * wid + 31); else { lanevalid = (sel >> ((t - 4) >> 2)) & 1u; skip = !__any(lanevalid); } }
        if (MODE == 1) { const int ks = 64 * (t0 + t), vq0 = 256 * p3 + 32 * wid; skip = (ks > vq0 + 31) || (ks + 63 < vq0 - 128) || ((ks >> lgL) != (vq0 >> lgL)); }
        if (skip) continue;
        const float sinit = (MODE == 0 && !lanevalid) ? NEGBIG : 0.f;
        f32x16 s0, s1;
#pragma unroll
        for (int r = 0; r < 16; ++r) { s0[r] = sinit; s1[r] = sinit; }
#pragma unroll
        for (int d0 = 0; d0 < NQ; ++d0) {
            const bf16x8 k0 = *(const LAS bf16x8*)(Kt + r32 * 256 + (((2 * d0 + hi) ^ (r32 & 15)) << 4));
            const bf16x8 k1 = *(const LAS bf16x8*)(Kt + (r32 + 32) * 256 + (((2 * d0 + hi) ^ (r32 & 15)) << 4));
            s0 = __builtin_amdgcn_mfma_f32_32x32x16_bf16(k0, qr[d0], s0, 0, 0, 0);
            s1 = __builtin_amdgcn_mfma_f32_32x32x16_bf16(k1, qr[d0], s1, 0, 0, 0);
        }
        if (MODE == 0) {
            if (t < 4 && 64 * t + 63 > 32 * wid) {
#pragma unroll
                for (int r = 0; r < 16; ++r) { const int kv = 64 * t + crow(r, hi); if (kv > qpos) s0[r] = NEGBIG; if (kv + 32 > qpos) s1[r] = NEGBIG; }
            }
        }
        if (MODE == 1 && !((64 * (t0 + t) >= 256 * p3 + 32 * wid + 31 - 128) && (64 * (t0 + t) + 63 <= 256 * p3 + 32 * wid) && (((64 * (t0 + t) + 63) >> lgL) == ((256 * p3 + 32 * wid) >> lgL)))) {
            const int vq = 256 * p3 + qpos, ks = 64 * (t0 + t);
#pragma unroll
            for (int r = 0; r < 16; ++r) {
                const int vk = ks + crow(r, hi); const int dl0 = vq - vk, dl1 = dl0 - 32;
                if (!(dl0 >= 0 && dl0 <= 128 && ((vk >> lgL) == (vq >> lgL)))) s0[r] = NEGBIG;
                if (!(dl1 >= 0 && dl1 <= 128 && (((vk + 32) >> lgL) == (vq >> lgL)))) s1[r] = NEGBIG;
            }
        }
        float mx = s0[0];
#pragma unroll
        for (int r = 1; r < 16; ++r) mx = fmaxf(mx, s0[r]);
#pragma unroll
        for (int r = 0; r < 16; ++r) mx = fmaxf(mx, s1[r]);
        { auto rr = __builtin_amdgcn_permlane32_swap(__float_as_uint(mx), __float_as_uint(mx), false, false); mx = fmaxf(__uint_as_float(rr[0]), __uint_as_float(rr[1])); }
        const float mn = fmaxf(m_run, mx), alpha = __builtin_amdgcn_exp2f(m_run - mn);
        m_run = mn;
        float ls = 0.f;
#pragma unroll
        for (int r = 0; r < 16; ++r) { s0[r] = __builtin_amdgcn_exp2f(s0[r] - mn); s1[r] = __builtin_amdgcn_exp2f(s1[r] - mn); ls += s0[r] + s1[r]; }
        l_run = l_run * alpha + ls;
        if (__any(alpha != 1.0f)) {
#pragma unroll
        for (int i = 0; i < 4; ++i)
#pragma unroll
            for (int r = 0; r < 16; ++r) o[i][r] *= alpha;
        }
        bf16x8 pa[4];
        { u32x4 w;
          w.x = cvtpk(s0[0], s0[1]); w.y = cvtpk(s0[2], s0[3]); w.z = cvtpk(s0[4], s0[5]); w.w = cvtpk(s0[6], s0[7]); pa[0] = __builtin_bit_cast(bf16x8, w);
          w.x = cvtpk(s0[8], s0[9]); w.y = cvtpk(s0[10], s0[11]); w.z = cvtpk(s0[12], s0[13]); w.w = cvtpk(s0[14], s0[15]); pa[1] = __builtin_bit_cast(bf16x8, w);
          w.x = cvtpk(s1[0], s1[1]); w.y = cvtpk(s1[2], s1[3]); w.z = cvtpk(s1[4], s1[5]); w.w = cvtpk(s1[6], s1[7]); pa[2] = __builtin_bit_cast(bf16x8, w);
          w.x = cvtpk(s1[8], s1[9]); w.y = cvtpk(s1[10], s1[11]); w.z = cvtpk(s1[12], s1[13]); w.w = cvtpk(s1[14], s1[15]); pa[3] = __builtin_bit_cast(bf16x8, w); }
#pragma unroll
        for (int db = 0; db < 4; ++db) {
#pragma unroll
            for (int ks = 0; ks < 4; ++ks) {
                const int tq = (lane & 15) >> 2, tp = lane & 3, tblk = (lane >> 4) & 1, tch = 4 * db + 2 * tblk + (tp >> 1);
                const int row0 = 16 * ks + 4 * hi + tq, row1 = row0 + 8;
                const v4i16_t lo = __builtin_amdgcn_ds_read_tr16_b64_v4i16((LAS v4i16_t*)(Vi + row0 * 256 + ((tch ^ (((row0 & 3) << 2) | ((row0 >> 2) & 3))) << 4) + 8 * (tp & 1)));
                const v4i16_t hi4 = __builtin_amdgcn_ds_read_tr16_b64_v4i16((LAS v4i16_t*)(Vi + row1 * 256 + ((tch ^ (((row1 & 3) << 2) | ((row1 >> 2) & 3))) << 4) + 8 * (tp & 1)));
                const bf16x8 va = (bf16x8){lo[0], lo[1], lo[2], lo[3], hi4[0], hi4[1], hi4[2], hi4[3]};
                o[db] = __builtin_amdgcn_mfma_f32_32x32x16_bf16(va, pa[ks], o[db], 0, 0, 0);
            }
        }
    }
    } else {
    for (int t = 0; t < NT; ++t) {
        load_tile(t);
        __syncthreads();
#pragma unroll
        for (int i = 0; i < KPT; ++i) { const int c = tid + 512 * i, row = c / KCH, ch = c % KCH; *(LAS u32x4*)(Ks + row * KP + ch * 16) = kreg[i]; }
        { const int kv = 2 * vpr, pos = (kv & ~12) | ((kv & 4) << 1) | ((kv & 8) >> 1);
          const unsigned a[4] = {vreg0.x, vreg0.y, vreg0.z, vreg0.w}, b[4] = {vreg1.x, vreg1.y, vreg1.z, vreg1.w};
#pragma unroll
          for (int e2 = 0; e2 < 4; ++e2) {
              const int d = vdc * 8 + 2 * e2;
              const unsigned w0 = (a[e2] & 0xffffu) | (b[e2] << 16), w1 = (a[e2] >> 16) | (b[e2] & 0xffff0000u);
              *(LAS unsigned*)(Vt + d * 144 + ((((pos >> 3) ^ (vdc & 7)) << 4) | ((pos & 7) << 1))) = w0;
              *(LAS unsigned*)(Vt + (d + 1) * 144 + ((((pos >> 3) ^ (vdc & 7)) << 4) | ((pos & 7) << 1))) = w1;
          } }
        __syncthreads();
        bool skip = false; bool lanevalid = true;
        if (MODE == 0) { if (t < 4) skip = (64 * t > 32 * wid + 31); else { lanevalid = (sel >> ((t - 4) >> 2)) & 1u; skip = !__any(lanevalid); } }
        if (MODE == 1) { const int ks = 64 * (t0 + t), vq0 = 256 * p3 + 32 * wid; skip = (ks > vq0 + 31) || (ks + 63 < vq0 - 128) || ((ks >> lgL) != (vq0 >> lgL)); }
        if (skip) continue;
        const float sinit = (MODE == 0 && !lanevalid) ? NEGBIG : 0.f;
        f32x16 s0, s1;
#pragma unroll
        for (int r = 0; r < 16; ++r) { s0[r] = sinit; s1[r] = sinit; }
#pragma unroll
        for (int d0 = 0; d0 < NQ; ++d0) {
            const bf16x8 k0 = *(const LAS bf16x8*)(Ks + r32 * KP + d0 * 32 + hi * 16);
            const bf16x8 k1 = *(const LAS bf16x8*)(Ks + (r32 + 32) * KP + d0 * 32 + hi * 16);
            s0 = __builtin_amdgcn_mfma_f32_32x32x16_bf16(k0, qr[d0], s0, 0, 0, 0);
            s1 = __builtin_amdgcn_mfma_f32_32x32x16_bf16(k1, qr[d0], s1, 0, 0, 0);
        }
        if (MODE == 0) {
            if (t < 4 && 64 * t + 63 > 32 * wid) {
#pragma unroll
                for (int r = 0; r < 16; ++r) { const int kv = 64 * t + crow(r, hi); if (kv > qpos) s0[r] = NEGBIG; if (kv + 32 > qpos) s1[r] = NEGBIG; }
            }
        }
        if (MODE == 1 && !((64 * (t0 + t) >= 256 * p3 + 32 * wid + 31 - 128) && (64 * (t0 + t) + 63 <= 256 * p3 + 32 * wid) && (((64 * (t0 + t) + 63) >> lgL) == ((256 * p3 + 32 * wid) >> lgL)))) {
            const int vq = 256 * p3 + qpos, ks = 64 * (t0 + t);
#pragma unroll
            for (int r = 0; r < 16; ++r) {
                const int vk = ks + crow(r, hi); const int dl0 = vq - vk, dl1 = dl0 - 32;
                if (!(dl0 >= 0 && dl0 <= 128 && ((vk >> lgL) == (vq >> lgL)))) s0[r] = NEGBIG;
                if (!(dl1 >= 0 && dl1 <= 128 && (((vk + 32) >> lgL) == (vq >> lgL)))) s1[r] = NEGBIG;
            }
        }
        float mx = s0[0];
#pragma unroll
        for (int r = 1; r < 16; ++r) mx = fmaxf(mx, s0[r]);
#pragma unroll
        for (int r = 0; r < 16; ++r) mx = fmaxf(mx, s1[r]);
        { auto rr = __builtin_amdgcn_permlane32_swap(__float_as_uint(mx), __float_as_uint(mx), false, false); mx = fmaxf(__uint_as_float(rr[0]), __uint_as_float(rr[1])); }
        const float mn = fmaxf(m_run, mx), alpha = __builtin_amdgcn_exp2f(m_run - mn);
        m_run = mn;
        float ls = 0.f;
#pragma unroll
        for (int r = 0; r < 16; ++r) { s0[r] = __builtin_amdgcn_exp2f(s0[r] - mn); s1[r] = __builtin_amdgcn_exp2f(s1[r] - mn); ls += s0[r] + s1[r]; }
        l_run = l_run * alpha + ls;
        if (__any(alpha != 1.0f)) {
#pragma unroll
        for (int i = 0; i < 4; ++i)
#pragma unroll
            for (int r = 0; r < 16; ++r) o[i][r] *= alpha;
        }
        bf16x8 pa[4];
        { u32x4 w;
          w.x = cvtpk(s0[0], s0[1]); w.y = cvtpk(s0[2], s0[3]); w.z = cvtpk(s0[4], s0[5]); w.w = cvtpk(s0[6], s0[7]); pa[0] = __builtin_bit_cast(bf16x8, w);
          w.x = cvtpk(s0[8], s0[9]); w.y = cvtpk(s0[10], s0[11]); w.z = cvtpk(s0[12], s0[13]); w.w = cvtpk(s0[14], s0[15]); pa[1] = __builtin_bit_cast(bf16x8, w);
          w.x = cvtpk(s1[0], s1[1]); w.y = cvtpk(s1[2], s1[3]); w.z = cvtpk(s1[4], s1[5]); w.w = cvtpk(s1[6], s1[7]); pa[2] = __builtin_bit_cast(bf16x8, w);
          w.x = cvtpk(s1[8], s1[9]); w.y = cvtpk(s1[10], s1[11]); w.z = cvtpk(s1[12], s1[13]); w.w = cvtpk(s1[14], s1[15]); pa[3] = __builtin_bit_cast(bf16x8, w); }
#pragma unroll
        for (int db = 0; db < 4; ++db) {
            const int d = 32 * db + r32;
#pragma unroll
            for (int ks = 0; ks < 4; ++ks) {
                const bf16x8 va = *(const LAS bf16x8*)(Vt + d * 144 + (((2 * ks + hi) ^ ((d >> 3) & 7)) << 4));
                o[db] = __builtin_amdgcn_mfma_f32_32x32x16_bf16(va, pa[ks], o[db], 0, 0, 0);
            }
        }
    }
    }
    { auto rr = __builtin_amdgcn_permlane32_swap(__float_as_uint(l_run), __float_as_uint(l_run), false, false); l_run = __uint_as_float(rr[0]) + __uint_as_float(rr[1]); }
    const float rl = 1.0f / l_run;
    asm volatile("s_waitcnt vmcnt(0)" ::: "memory");
#pragma unroll
    for (int db = 0; db < 4; ++db)
#pragma unroll
        for (int a = 0; a < 4; ++a) {
            LAS u32x2* sp = (LAS u32x2*)(stg + r32 * 256 + (((4 * db + a) ^ (r32 & 15)) << 4) + hi * 8);
            u32x2 w;
            if (MODE == 1) { w.x = cvtpk(o[db][4 * a] * rl, o[db][4 * a + 1] * rl); w.y = cvtpk(o[db][4 * a + 2] * rl, o[db][4 * a + 3] * rl); }
            else { const u32x2 z = *sp; w.x = cvtpk(o[db][4 * a] * rl * bflo(z.x), o[db][4 * a + 1] * rl * bfhi(z.x)); w.y = cvtpk(o[db][4 * a + 2] * rl * bflo(z.y), o[db][4 * a + 3] * rl * bfhi(z.y)); }
            *sp = w;
        }
    asm volatile("s_waitcnt lgkmcnt(0)" ::: "memory");
    const int erow = lane >> 4, epos = lane & 15;
    if (MODE == 1) {
        const int g = p0, sh = 2 * g;
#pragma unroll
        for (int i = 0; i < 8; ++i) {
            const int row = 4 * i + erow, v = 256 * p3 + 32 * wid + row, res = v >> lgL, ii = v & ((1 << lgL) - 1), p = (ii << sh) + res;
            const size_t tok = (size_t)p1 * SEQ + p;
            const u32x4 ov = *(const LAS u32x4*)(stg + row * 256 + epos * 16);
            *(u32x4*)(C.OB + ((size_t)g * MTOK + tok) * 512 + p2 * 128 + ((epos ^ (row & 15)) << 3)) = ov;
        }
        { const int v = 256 * p3 + qpos, res = v >> lgL, ii = v & ((1 << lgL) - 1), p = (ii << sh) + res; const size_t tok = (size_t)p1 * SEQ + p;
          if (hi == 0) C.LSE[((size_t)g * MTOK + tok) * 4 + p2] = m_run + __builtin_amdgcn_logf(l_run); }
    } else {
        const size_t tok0 = (size_t)p0 * SEQ + p2 * 256 + 32 * wid;
        bf16_t* yp = (MODE == 0) ? C.Y + tok0 * LDH + p1 * 128 : C.Y + tok0 * LDH + 1536 + p1 * 256 + p3 * 128;
#pragma unroll
        for (int i = 0; i < 8; ++i) {
            const int row = 4 * i + erow;
            const u32x4 ov = *(const LAS u32x4*)(stg + row * 256 + epos * 16);
            *(u32x4*)(yp + (size_t)row * LDH + ((epos ^ (row & 15)) << 3)) = ov;
        }
    }
    asm volatile("s_waitcnt lgkmcnt(0)" ::: "memory");
}

constexpr int N_ATT_ITEMS = 1792;
__device__ __forceinline__ void attn_phase(LAS unsigned char* lds, const AttnC& C, unsigned* counter, unsigned* mkv_cnt) {
    LAS int* wq = (LAS int*)(lds + 139264);
    bool mkv_ready = false;
    int nxt_idx = 0;
    if (threadIdx.x == 0) nxt_idx = (int)atomicAdd(counter, 1u);
    for (;;) {
        __syncthreads();
        if (threadIdx.x == 0) wq[0] = nxt_idx;
        __syncthreads();
        int idx = wq[0];
        if (idx >= N_ATT_ITEMS) break;
        if (threadIdx.x == 0) nxt_idx = (int)atomicAdd(counter, 1u);
        if (idx < 192) { attn_unit<128, 0>(lds, C, (idx & 63) >> 3, idx & 7, 7 - (idx >> 6), 0); continue; } idx -= 192;
        if (idx < 192) { attn_unit<128, 0>(lds, C, (idx & 63) >> 3, idx & 7, 4 - (idx >> 6), 0); continue; } idx -= 192;
        if (idx < 768) { attn_unit<128, 1>(lds, C, idx >> 8, (idx >> 5) & 7, (idx >> 3) & 3, idx & 7); continue; } idx -= 768;
        if (idx < 512) {
            if (!mkv_ready) {
                if (threadIdx.x == 0) {
                    unsigned spin = 0;
                    while (__hip_atomic_load(mkv_cnt, __ATOMIC_RELAXED, __HIP_MEMORY_SCOPE_AGENT) < 64u) { __builtin_amdgcn_s_sleep(2); if (++spin > (1u << 22)) break; }
                    __builtin_amdgcn_fence(__ATOMIC_ACQUIRE, "agent");
                    asm volatile("s_waitcnt vmcnt(0)" ::: "memory");
                }
                __syncthreads();
                mkv_ready = true;
            }
            attn_unit<256, 2>(lds, C, idx >> 6, (idx >> 4) & 3, (idx >> 1) & 7, idx & 1); continue;
        } idx -= 512;
        attn_unit<128, 0>(lds, C, (idx & 63) >> 3, idx & 7, 1 - (idx >> 6), 0);
    }
}

__device__ __forceinline__ int srccol_in(int v) {
    const int pn = v >> 8; const bool rp = (pn < 8) || (pn >= 16 && pn < 28);
    if (!rp) return v;
    const int dp = v & 127; const int d = ((dp >> 2) & 1) * 64 + (dp >> 5) * 16 + ((dp >> 3) & 3) * 4 + (dp & 3);
    return (v & ~127) + d;
}
template <bool PERMC, bool NTS = false>
__device__ __forceinline__ void transpose_item(const float* W, int Nsrc, int col_off, bf16_t* WT, int ldt, int row_off, int koff, int nblk, LAS float* scr, int item, int lane) {
    const int kb = item / nblk, nb = item % nblk, k0 = 64 * kb, n0 = 32 * nb;
    const int vcol = n0 + (lane & 31); const int sc = col_off + (PERMC ? srccol_in(vcol) : vcol);
#pragma unroll 8
    for (int i = 0; i < 32; ++i) { const int kk = 2 * i + (lane >> 5); scr[kk * 33 + (lane & 31)] = __builtin_nontemporal_load(W + (size_t)(k0 + kk) * Nsrc + sc); }
    asm volatile("s_waitcnt lgkmcnt(0)" ::: "memory");
    const int c = lane & 7;
#pragma unroll
    for (int j = 0; j < 4; ++j) { const int n = (lane >> 3) + 8 * j; const LAS float* s = scr + (8 * c) * 33 + n;
        u32x4 o; o.x = cvtpk(s[0 * 33], s[1 * 33]); o.y = cvtpk(s[2 * 33], s[3 * 33]); o.z = cvtpk(s[4 * 33], s[5 * 33]); o.w = cvtpk(s[6 * 33], s[7 * 33]);
        if (NTS) __builtin_nontemporal_store(o, (u32x4*)(WT + (size_t)(row_off + n0 + n) * ldt + koff + k0 + 8 * c)); else *(u32x4*)(WT + (size_t)(row_off + n0 + n) * ldt + koff + k0 + 8 * c) = o; }
    asm volatile("s_waitcnt lgkmcnt(0)" ::: "memory");
}
__device__ __forceinline__ void rms_row(const float* xrow, const float* g, bf16_t* orow, int lane) {
    const f32x4* xr = (const f32x4*)xrow + lane; const f32x4* gr = (const f32x4*)g + lane;
    f32x4 v[8]; float s = 0.f;
#pragma unroll
    for (int j = 0; j < 8; ++j) { v[j] = __builtin_nontemporal_load(xr + 64 * j); s += (v[j][0] * v[j][0] + v[j][1] * v[j][1]) + (v[j][2] * v[j][2] + v[j][3] * v[j][3]); }
    const float rs = 1.0f / sqrtf(wave_sum(s) * (1.0f / DM) + 1e-6f);
    u32x2* o8 = (u32x2*)orow + lane;
#pragma unroll
    for (int j = 0; j < 8; ++j) { const f32x4 gv = gr[64 * j]; u32x2 w; w.x = cvtpk(v[j][0] * rs * gv[0], v[j][1] * rs * gv[1]); w.y = cvtpk(v[j][2] * rs * gv[2], v[j][3] * rs * gv[3]); o8[64 * j] = w; }
}

#define XB_TMO      128
#define XB_XCNT(j)  (256  + 64 * (j))
#define XB_XSUB(j)  (1280 + 64 * (j))
#define XB_XGEN(j)  (2304 + 64 * (j))
#define XB_TOP      3328
#define XB_TOPGEN   3392
#define XCD_BAR_WORDS 3456
#define XB_SPIN_CAP (1u << 18)
__device__ __forceinline__ unsigned xb_ld(unsigned* p)              { return __hip_atomic_load(p, __ATOMIC_RELAXED, __HIP_MEMORY_SCOPE_AGENT); }
__device__ __forceinline__ unsigned xb_add(unsigned* p, unsigned v) { return __hip_atomic_fetch_add(p, v, __ATOMIC_RELAXED, __HIP_MEMORY_SCOPE_AGENT); }
__device__ __forceinline__ unsigned xb_xcc_id() { return (unsigned)__builtin_amdgcn_s_getreg((3 << 11) | 20) & 0xFu; }
#define XB_SPIN(cond, bar) do { unsigned _sp = 0; while (cond) { __builtin_amdgcn_s_sleep(1); \
    if ((++_sp & 255u) == 0u) { if (xb_ld(&(bar)[XB_TMO])) break; if (_sp > XB_SPIN_CAP) { atomicAdd(&(bar)[XB_TMO], 1u); break; } } } } while (0)
struct XcdBarrier { unsigned* bar; unsigned x; volatile LAS unsigned* st; };
__device__ __forceinline__ XcdBarrier xcd_barrier_post(unsigned* bar, volatile LAS unsigned* st) {
    XcdBarrier b; b.bar = bar; b.x = xb_xcc_id(); b.st = st;
    if (threadIdx.x == 0) (void)xb_add(&bar[XB_XCNT(b.x)], 1u);
    return b;
}
__device__ __forceinline__ void xcd_barrier_complete(unsigned* bar, unsigned x, unsigned& nloc, unsigned& nx) {
    const unsigned G = gridDim.x * gridDim.y * gridDim.z;
    unsigned sum, cnt, mine, sp = 0u;
    for (;;) {
        sum = 0u; cnt = 0u; mine = 0u;
#pragma unroll
        for (unsigned j = 0; j < 16; ++j) { const unsigned c = xb_ld(&bar[XB_XCNT(j)]); sum += c; cnt += (c > 0u) ? 1u : 0u; mine = (j == x) ? c : mine; }
        if (sum == G) break;
        __builtin_amdgcn_s_sleep(1);
        if ((++sp & 255u) == 0u) { if (xb_ld(&bar[XB_TMO])) break; if (sp > XB_SPIN_CAP) { atomicAdd(&bar[XB_TMO], 1u); break; } }
    }
    nloc = mine > 0u ? mine : 1u; nx = cnt > 0u ? cnt : 1u;
}
__device__ __forceinline__ void xcd_barrier(const XcdBarrier& b) {
    asm volatile("s_waitcnt vmcnt(0)" ::: "memory");
    __syncthreads();
    if (threadIdx.x == 0) {
        unsigned* bar = b.bar;
        __builtin_amdgcn_s_waitcnt(0);
        unsigned nloc = b.st[0], nx = b.st[1];
        if (nloc == 0u) { xcd_barrier_complete(bar, b.x, nloc, nx); b.st[0] = nloc; b.st[1] = nx; }
        const unsigned old = xb_add(&bar[XB_XSUB(b.x)], 1u);
        const unsigned gen = old / nloc;
        if (old + 1u == (gen + 1u) * nloc) {
            __builtin_amdgcn_fence(__ATOMIC_RELEASE, "agent");
            asm volatile("s_waitcnt vmcnt(0)" ::: "memory");
            const unsigned og = xb_add(&bar[XB_TOP], 1u);
            const unsigned tg = og / nx;
            if (og + 1u == (tg + 1u) * nx) xb_add(&bar[XB_TOPGEN], 1u);
            else XB_SPIN(xb_ld(&bar[XB_TOPGEN]) == tg, bar);
            __builtin_amdgcn_fence(__ATOMIC_ACQUIRE, "agent");
            xb_add(&bar[XB_XGEN(b.x)], 1u);
            asm volatile("s_waitcnt vmcnt(0)" ::: "memory");
        } else {
            XB_SPIN(xb_ld(&bar[XB_XGEN(b.x)]) == gen, bar);
            __builtin_amdgcn_fence(__ATOMIC_ACQUIRE, "agent");
            asm volatile("s_waitcnt vmcnt(0)" ::: "memory");
        }
    }
    __syncthreads();
}

struct Args { const float* in[11]; float* out; unsigned char* ws; double inv[64]; };
constexpr int LDS_BYTES = 147456;
#ifndef PHASES
#define PHASES 127
#endif

__global__ void __launch_bounds__(512) fwd_megakernel(Args args) {
    extern __shared__ __attribute__((aligned(16))) unsigned char lds_raw[];
    LAS unsigned char* lds = (LAS unsigned char*)lds_raw;
    cg::grid_group grid = cg::this_grid();
#define FRESH_IDS int tid_ = threadIdx.x; asm volatile("" : "+v"(tid_)); const int tid = tid_, lane = tid & 63, wave = __builtin_amdgcn_readfirstlane(tid >> 6); (void)lane; (void)wave; (void)tid
    const int G = gridDim.x, bx = blockIdx.x;
    const int vcu = (G % 8 == 0) ? (bx % 8) * (G / 8) + bx / 8 : bx;
    unsigned char* ws = args.ws; unsigned char* dout = (unsigned char*)args.out;
    const float* x = args.in[0]; const float* mem = args.in[1]; const float* g_in = args.in[2]; const float* g_mem = args.in[3];
    const float* w_in = args.in[4]; const float* w_mkv = args.in[5]; const float* w_pa = args.in[6]; const float* w_pb = args.in[7]; const float* w_pm = args.in[8];
    const float* w_out = args.in[9]; const float* g_fin = args.in[10];
    unsigned* ctl = (unsigned*)(ws + WS_CTL);
    volatile LAS unsigned* bst = (volatile LAS unsigned*)(lds + LDS_BYTES - 256);
    if (threadIdx.x < 2) bst[threadIdx.x] = 0u;
    __syncthreads();
    const XcdBarrier xbar = xcd_barrier_post(ctl + 4096, bst); float* ssq = (float*)(ws + WS_SSQ); float* rope = (float*)(ws + WS_ROPE); float* kmp = (float*)(ws + WS_KMP); float* lse = (float*)(ws + WS_LSE);
    bf16_t* WOUT = (bf16_t*)(ws + WS_WOUT); bf16_t* BTG = (bf16_t*)(ws + WS_BTG); bf16_t* BT1 = (bf16_t*)(ws + WS_BT1); bf16_t* OB = (bf16_t*)(ws + WS_OB);
    bf16_t* H = (bf16_t*)(ws + WS_H); bf16_t* PROJ = (bf16_t*)(ws + WS_PROJ); bf16_t* GB = (bf16_t*)(ws + WS_G); bf16_t* MERGED = (bf16_t*)(ws + WS_MERGED);
    bf16_t* Y = (bf16_t*)(dout + DO_Y); bf16_t* MKV = (bf16_t*)(dout + DO_MKV); bf16_t* WCAT = (bf16_t*)(dout + DO_WCAT);

    if (PHASES & 1) {
        FRESH_IDS;
        const int gw = vcu * 8 + wave, NGW = G * 8;
        LAS float* scr = (LAS float*)(lds + wave * 16384);
        constexpr int I1 = 32 * 352, I2 = 32 * 64, I3 = 32 * 192, I4a = 16 * 64, I4b = 8 * 64, I4c = 16 * 64, I5 = 32 * 64;
        constexpr int NIT = I1 + I2 + I3 + I4a + I4b + I4c + I5;
        for (int it = gw; it < NIT; it += NGW) {
            int r = it;
            if (r < I1) { transpose_item<true>(w_in, 17408, 0, BT1, DM, 0, 0, 352, scr, r, lane); continue; } r -= I1;
            if (r < I2) { transpose_item<false>(w_mkv, 2048, 0, BT1, DM, 11264, 0, 64, scr, r, lane); continue; } r -= I2;
            if (r < I3) { transpose_item<false, true>(w_in, 17408, 11264, BTG, LDH, 0, 0, 192, scr, r, lane); continue; } r -= I3;
            if (r < I4a) { transpose_item<false, true>(w_pa, 2048, 0, WCAT, LDH, 0, 0, 64, scr, r, lane); continue; } r -= I4a;
            if (r < I4b) { transpose_item<false, true>(w_pb, 2048, 0, WCAT, LDH, 0, 1024, 64, scr, r, lane); continue; } r -= I4b;
            if (r < I4c) { transpose_item<false, true>(w_pm, 2048, 0, WCAT, LDH, 0, 1536, 64, scr, r, lane); continue; } r -= I4c;
            transpose_item<false, true>(w_out, 2048, 0, WOUT, DM, 0, 0, 64, scr, r, lane);
        }
        for (int m = gw; m < MTOK + MROWS; m += NGW) {
            if (m < MTOK) rms_row(x + (size_t)m * DM, g_in, H + (size_t)m * LDH, lane);
            else rms_row(mem + (size_t)(m - MTOK) * DM, g_mem, H + (size_t)m * LDH, lane);
        }
        for (int e = vcu * 512 + tid; e < SEQ * 64; e += G * 512) {
            const int pos = e >> 6, i = e & 63;
            const double ang = (double)pos * args.inv[i];
            const double kq = rint(ang * 0.63661977236758134308);
            double r = fma(-kq, 1.57079632679489655800e+00, ang); r = fma(-kq, 6.12323399573676603587e-17, r);
            const double r2 = r * r;
            const double sr = r + r * r2 * (-1.0 / 6 + r2 * (1.0 / 120 + r2 * (-1.0 / 5040 + r2 * (1.0 / 362880 + r2 * (-1.0 / 39916800 + r2 * (1.0 / 6227020800.0))))));
            const double cr = 1.0 + r2 * (-0.5 + r2 * (1.0 / 24 + r2 * (-1.0 / 720 + r2 * (1.0 / 40320 + r2 * (-1.0 / 3628800 + r2 * (1.0 / 479001600.0))))));
            const int q = (int)((long long)kq & 3);
            const double cc = (q == 0) ? cr : (q == 1) ? -sr : (q == 2) ? -cr : sr;
            const double ss = (q == 0) ? sr : (q == 1) ? cr : (q == 2) ? -sr : -cr;
            rope[2 * e] = (float)cc; rope[2 * e + 1] = (float)ss;
        }
    }
    xcd_barrier(xbar);
    if (args.ws == nullptr) grid.sync();
    if (PHASES & 2) {
        Sched1 S{(const char*)H, (const char*)BT1, G, bx};
        Epi1 E{PROJ, MKV, kmp, rope};
        pg8::gemm_phase(lds, LDH, DM, S, E);
    }
    xcd_barrier(xbar);
    if ((PHASES & 2) && bx < 64) {
        Sched1m S{(const char*)H, (const char*)BT1, bx};
        Epi1 E{PROJ, MKV, kmp, rope};
        pg8::gemm_phase(lds, LDH, DM, S, E);
        asm volatile("s_waitcnt vmcnt(0)" ::: "memory");
        __syncthreads();
        if (threadIdx.x == 0) {
            __builtin_amdgcn_fence(__ATOMIC_RELEASE, "agent");
            asm volatile("s_waitcnt vmcnt(0)" ::: "memory");
            (void)__hip_atomic_fetch_add(ctl + 96, 1u, __ATOMIC_RELAXED, __HIP_MEMORY_SCOPE_AGENT);
        }
    }
    if (PHASES & 4) {
        AttnC C{PROJ, MKV, kmp, Y, OB, lse};
        attn_phase(lds, C, ctl + 64, ctl + 96);
    }
    xcd_barrier(xbar);
    if (PHASES & 8) {
        FRESH_IDS;
        for (int e = vcu * 512 + tid; e < MTOK * 64; e += G * 512) {
            const int tok = e >> 6, c8 = e & 63, j = c8 >> 4;
            const float l0 = lse[(size_t)tok * 4 + j], l1 = lse[((size_t)MTOK + tok) * 4 + j], l2 = lse[((size_t)2 * MTOK + tok) * 4 + j];
            const float mx = fmaxf(l0, fmaxf(l1, l2));
            float w0 = __builtin_amdgcn_exp2f(l0 - mx), w1 = __builtin_amdgcn_exp2f(l1 - mx), w2 = __builtin_amdgcn_exp2f(l2 - mx);
            const float inv = 1.0f / (w0 + w1 + w2); w0 *= inv; w1 *= inv; w2 *= inv;
            const u32x4 a = *(const u32x4*)(OB + (size_t)tok * 512 + c8 * 8), b = *(const u32x4*)(OB + ((size_t)MTOK + tok) * 512 + c8 * 8), c = *(const u32x4*)(OB + ((size_t)2 * MTOK + tok) * 512 + c8 * 8);
            const u32x4 z = *(const u32x4*)(PROJ + (size_t)tok * LDP + C_ZB + c8 * 8);
            u32x4 w;
            w.x = cvtpk((w0 * bflo(a.x) + w1 * bflo(b.x) + w2 * bflo(c.x)) * bflo(z.x), (w0 * bfhi(a.x) + w1 * bfhi(b.x) + w2 * bfhi(c.x)) * bfhi(z.x));
            w.y = cvtpk((w0 * bflo(a.y) + w1 * bflo(b.y) + w2 * bflo(c.y)) * bflo(z.y), (w0 * bfhi(a.y) + w1 * bfhi(b.y) + w2 * bfhi(c.y)) * bfhi(z.y));
            w.z = cvtpk((w0 * bflo(a.z) + w1 * bflo(b.z) + w2 * bflo(c.z)) * bflo(z.z), (w0 * bfhi(a.z) + w1 * bfhi(b.z) + w2 * bfhi(c.z)) * bfhi(z.z));
            w.w = cvtpk((w0 * bflo(a.w) + w1 * bflo(b.w) + w2 * bflo(c.w)) * bflo(z.w), (w0 * bfhi(a.w) + w1 * bfhi(b.w) + w2 * bfhi(c.w)) * bfhi(z.w));
            *(u32x4*)(Y + (size_t)tok * LDH + 1024 + c8 * 8) = w;
        }
    }
    xcd_barrier(xbar);
    if (PHASES & 16) {
        Sched3 S{(const char*)H, (const char*)BTG, (const char*)Y, (const char*)WCAT, G, vcu};
        Epi3 E{GB, MERGED};
        pg8::gemm_phase(lds, LDH, LDH, S, E);
    }
    xcd_barrier(xbar);
    if (PHASES & 32) {
        Sched4 S{(const char*)MERGED, (const char*)WOUT, G, vcu};
        Epi4 E{x, args.out, (float*)(ctl + 16384), ctl + 32768, g_fin};
        pg8::gemm_phase(lds, DM, DM, S, E);
    }
}

extern "C" void kernel_launch(void* const* d_in, const int* in_sizes, int n_in, void* d_out, int out_size, void* d_ws, size_t ws_size, hipStream_t stream) {
    static int grid_blocks = 0;
    if (grid_blocks == 0) {
        if (n_in != 11 || out_size != MTOK * DM || ws_size < WS_END) { fprintf(stderr, "kernel_launch: unexpected shapes (n_in %d out %d ws %zu)\n", n_in, out_size, ws_size); grid_blocks = -1; return; }
        int dev = 0, cus = 0, per_cu = 0;
        hipGetDevice(&dev);
        hipDeviceGetAttribute(&cus, hipDeviceAttributeMultiprocessorCount, dev);
        if (hipFuncSetAttribute((const void*)fwd_megakernel, hipFuncAttributeMaxDynamicSharedMemorySize, LDS_BYTES) != hipSuccess) { fprintf(stderr, "kernel_launch: hipFuncSetAttribute failed\n"); grid_blocks = -1; return; }
        if (hipOccupancyMaxActiveBlocksPerMultiprocessor(&per_cu, (const void*)fwd_megakernel, 512, LDS_BYTES) != hipSuccess || per_cu < 1) { fprintf(stderr, "kernel_launch: occupancy query gave %d\n", per_cu); per_cu = 1; }
        (void)hipGetLastError();
        grid_blocks = cus * 1;
    }
    if (grid_blocks < 0) return;
    hipMemsetAsync((char*)d_ws + WS_CTL, 0, 163840, stream);
    Args a{};
    for (int i = 0; i < 11; ++i) a.in[i] = (const float*)d_in[i];
    a.out = (float*)d_out; a.ws = (unsigned char*)d_ws;
    for (int i = 0; i < 64; ++i) a.inv[i] = pow(10000.0, -(double)i / 64.0);
    void* kargs[] = {&a};
    hipError_t e = hipLaunchCooperativeKernel((const void*)fwd_megakernel, dim3(grid_blocks), dim3(512), kargs, LDS_BYTES, stream);
    if (e != hipSuccess) fprintf(stderr, "cooperative launch failed: %s (grid %d)\n", hipGetErrorString(e), grid_blocks);
}
```

```cpp
#include <hip/hip_runtime.h>
#include <hip/hip_cooperative_groups.h>
#include <cstdio>
#include <cstdint>
#include <cmath>
namespace cg = cooperative_groups;

#define LAS __attribute__((address_space(3)))
typedef unsigned short bf16_t;
typedef short bf16x8 __attribute__((ext_vector_type(8)));
typedef float f32x2 __attribute__((ext_vector_type(2)));
typedef float f32x4 __attribute__((ext_vector_type(4)));
typedef float f32x16 __attribute__((ext_vector_type(16)));
typedef unsigned u32x2 __attribute__((ext_vector_type(2)));
typedef unsigned u32x4 __attribute__((ext_vector_type(4)));
typedef __bf16 bf16x2_t __attribute__((ext_vector_type(2)));
typedef short v4i16_t __attribute__((ext_vector_type(4)));

constexpr int DM = 2048, NB = 8, SEQ = 2048, MTOK = NB * SEQ;
constexpr int MEML = 256, MROWS = NB * MEML;
constexpr int LDP = 11264;
constexpr int LDH = 2560;
constexpr int LDG = 6144;
constexpr int C_QA = 0, C_KA = 1024, C_VA = 2048, C_ZA = 3072, C_QB = 4096, C_KB = 5632, C_VB = 7168, C_ZB = 8704, C_QM = 9216, C_ZM = 10240;
constexpr float LOG2E = 1.4426950408889634f;
constexpr float QS128 = 0.08838834764831845f * LOG2E;
constexpr float QS256 = 0.0625f * LOG2E;
constexpr float NEGBIG = -1e30f;

constexpr size_t MiB = 1u << 20;
constexpr size_t WS_CTL = 0, WS_SSQ = 1 * MiB, WS_ROPE = 3 * MiB, WS_KMP = 4 * MiB, WS_LSE = 5 * MiB, WS_WOUT = 6 * MiB, WS_BTG = 14 * MiB,
                 WS_BT1 = 44 * MiB, WS_OB = 44 * MiB  , WS_H = 96 * MiB, WS_PROJ = 186 * MiB, WS_G = 186 * MiB  ,
                 WS_MERGED = 378 * MiB, WS_END = 538 * MiB;
constexpr size_t DO_Y = 0, DO_MKV = 80 * MiB, DO_WCAT = 88 * MiB;

__device__ __forceinline__ unsigned cvtpk(float lo, float hi) { f32x2 v = {lo, hi}; bf16x2_t b = __builtin_convertvector(v, bf16x2_t); return __builtin_bit_cast(unsigned, b); }
__device__ __forceinline__ float bflo(unsigned w) { return __uint_as_float(w << 16); }
__device__ __forceinline__ float bfhi(unsigned w) { return __uint_as_float(w & 0xffff0000u); }
__device__ __forceinline__ float wave_sum(float v) {
#pragma unroll
    for (int o = 1; o < 64; o <<= 1) v += __shfl_xor(v, o);
    return v;
}
__device__ __forceinline__ float fast_sigmoid(float v) { return __builtin_amdgcn_rcpf(1.0f + __builtin_amdgcn_exp2f(-v * LOG2E)); }
__device__ __forceinline__ float gate_sigmoid(float v) { return fast_sigmoid(fminf(fmaxf(v, -60.0f), 60.0f)); }

namespace pg8 {
constexpr int BM = 256, BK = 64, HALF = 128, HTB = HALF * BK * 2, STAGE_BYTES = 8 * HTB;
__host__ __device__ __forceinline__ int lds_byte(int r, int c) { const int st = (r >> 4) * 2 + (c >> 5), rr = r & 15, cc = c & 31, ob = rr * 64 + cc * 2; return st * 1024 + (ob ^ (((ob >> 9) & 1) << 5)); }
__host__ __device__ __forceinline__ void stage_rc(int b, int& R, int& C) { const int st = b / 1024, sb = b % 1024, swz = sb ^ (((sb >> 9) & 1) << 5); R = (st >> 1) * 16 + swz / 64; C = (st & 1) * 32 + (swz % 64) / 2; }
__host__ __device__ __forceinline__ int perm32(int rho) { const int n = rho >> 4, i = rho & 15; return 8 * (i >> 2) + 4 * n + (i & 3); }

struct Unit { const char* a; const char* b; int nt; int kind; int pm; int pn; };
template <class Sched, class Epi>
__device__ __forceinline__ void gemm_phase(LAS unsigned char* lds, const int ldA, const int ldB, const Sched& S, const Epi& E) {
    int tid_ = threadIdx.x; asm volatile("" : "+v"(tid_));
    const int tid = tid_, wid = __builtin_amdgcn_readfirstlane(tid >> 6), lane = tid & 63, wr = wid >> 2, wc = wid & 3, fr = lane & 15, fq = lane >> 4;
    unsigned voffA[2], voffB[2];
#pragma unroll
    for (int i = 0; i < 2; ++i) { int R, C; stage_rc(tid * 16 + i * 8192, R, C); const int Rb = (R & ~31) + perm32(R & 31);
        voffA[i] = (unsigned)(R * ldA + C) * 2u; voffB[i] = (unsigned)(Rb * ldB + C) * 2u; }
    const size_t kstep = (size_t)(BK * 2);
    const size_t hstepA = (size_t)HALF * ldA * 2, hstepB = (size_t)HALF * ldB * 2;
    const unsigned ldsw = (unsigned)wid * 1024u;
    const int aoff = lds_byte(wr * 64 + fr, fq * 8), boff = lds_byte(wc * 32 + fr, fq * 8);
#define PG8_SA(b, h) (((b) * 2 + (h)) * HTB)
#define PG8_SB(b, h) ((4 + (b) * 2 + (h)) * HTB)
#define PG8_STAGE(bufoff, gbase, voff) do { _Pragma("unroll") for (int _i = 0; _i < 2; ++_i) \
        __builtin_amdgcn_global_load_lds((const unsigned*)((const char*)(gbase) + (voff)[_i]), (LAS unsigned*)(lds + (bufoff) + ldsw + _i * 8192), 16, 0, 0); } while (0)
#define PG8_LDA(dst, b, h) do { _Pragma("unroll") for (int m = 0; m < 4; ++m) _Pragma("unroll") for (int k = 0; k < 2; ++k) dst[m][k] = *(const LAS bf16x8*)(lds + PG8_SA(b, h) + aoff + m * 2048 + k * 1024); } while (0)
#define PG8_LDB(dst, b, h) do { _Pragma("unroll") for (int n = 0; n < 2; ++n) _Pragma("unroll") for (int k = 0; k < 2; ++k) dst[n][k] = *(const LAS bf16x8*)(lds + PG8_SB(b, h) + boff + n * 2048 + k * 1024); } while (0)
#define PG8_MMA(ai, bj, At, Bt) do { __builtin_amdgcn_s_setprio(1); _Pragma("unroll") for (int m = 0; m < 4; ++m) _Pragma("unroll") for (int n = 0; n < 2; ++n) _Pragma("unroll") for (int k = 0; k < 2; ++k) \
        acc[ai][bj][m][n] = __builtin_amdgcn_mfma_f32_16x16x32_bf16(Bt[n][k], At[m][k], acc[ai][bj][m][n], 0, 0, 0); __builtin_amdgcn_s_setprio(0); } while (0)
#define PG8_WAIT_V(n) asm volatile("s_waitcnt vmcnt(" #n ")" ::: "memory")
#define PG8_WAIT_L(n) asm volatile("s_waitcnt lgkmcnt(" #n ")" ::: "memory")
#define PG8_BAR __builtin_amdgcn_s_barrier()
#define PG8_SCHED __builtin_amdgcn_sched_barrier(0)
    Unit cur, nxt; int ui = 0;
    if (!S.next(0, cur)) return;
    f32x4 acc[2][2][4][2];
#pragma unroll
    for (int a = 0; a < 2; ++a)
#pragma unroll
        for (int b = 0; b < 2; ++b)
#pragma unroll
            for (int m = 0; m < 4; ++m)
#pragma unroll
                for (int n = 0; n < 2; ++n) acc[a][b][m][n] = (f32x4){0.f, 0.f, 0.f, 0.f};
    bf16x8 At[4][2], B0[2][2], B1[2][2];
    const char* cA = cur.a; const char* cB = cur.b;
    PG8_STAGE(PG8_SB(0, 0), cB, voffB); PG8_STAGE(PG8_SB(0, 1), cB + hstepB, voffB); PG8_STAGE(PG8_SA(0, 0), cA, voffA); PG8_STAGE(PG8_SA(0, 1), cA + hstepA, voffA);
    if (wr == 1) PG8_BAR;
    PG8_WAIT_V(2); PG8_BAR;
    PG8_STAGE(PG8_SB(1, 0), cB + kstep, voffB); PG8_STAGE(PG8_SA(1, 0), cA + kstep, voffA); PG8_STAGE(PG8_SB(1, 1), cB + hstepB + kstep, voffB);
    PG8_WAIT_V(6); PG8_BAR;
    for (;;) {
        const bool has_next = S.next(ui + 1, nxt);
        const char* nA = has_next ? nxt.a : cA; const char* nB = has_next ? nxt.b : cB;
        const int nt = cur.nt;
        for (int t = 0; t < nt; t += 2) {
            if constexpr (Epi::HOOK) E.hook(acc, cur, t, wr, wc, fr, fq);
            const bool last = (t == nt - 2);
            const char* a1 = cA + (size_t)(t + 1) * kstep;
            const char* a2 = last ? nA : cA + (size_t)(t + 2) * kstep; const char* b2 = last ? nB : cB + (size_t)(t + 2) * kstep;
            const char* a3 = a2 + kstep; const char* b3 = b2 + kstep;
            PG8_LDB(B0, 0, 0); PG8_LDB(B1, 0, 1); PG8_SCHED; PG8_LDA(At, 0, 0); PG8_STAGE(PG8_SA(1, 1), a1 + hstepA, voffA);
            PG8_WAIT_V(8); PG8_WAIT_L(0); PG8_BAR; PG8_MMA(0, 0, At, B0); PG8_MMA(0, 1, At, B1); PG8_BAR; PG8_SCHED;
            PG8_LDA(At, 0, 1); PG8_STAGE(PG8_SB(0, 0), b2, voffB); PG8_STAGE(PG8_SB(0, 1), b2 + hstepB, voffB); PG8_STAGE(PG8_SA(0, 0), a2, voffA);
            PG8_WAIT_V(8); PG8_WAIT_L(0); PG8_BAR; PG8_MMA(1, 0, At, B0); PG8_MMA(1, 1, At, B1); PG8_BAR; PG8_SCHED;
            PG8_LDB(B0, 1, 0); PG8_LDB(B1, 1, 1); PG8_SCHED; PG8_LDA(At, 1, 0); PG8_STAGE(PG8_SA(0, 1), a2 + hstepA, voffA);
            PG8_WAIT_V(8); PG8_WAIT_L(0); PG8_BAR; PG8_MMA(0, 0, At, B0); PG8_MMA(0, 1, At, B1); PG8_BAR; PG8_SCHED;
            PG8_LDA(At, 1, 1); PG8_STAGE(PG8_SB(1, 0), b3, voffB); PG8_STAGE(PG8_SB(1, 1), b3 + hstepB, voffB); PG8_STAGE(PG8_SA(1, 0), a3, voffA);
            PG8_WAIT_V(8); PG8_WAIT_L(0); PG8_BAR; PG8_MMA(1, 0, At, B0); PG8_MMA(1, 1, At, B1); PG8_BAR; PG8_SCHED;
        }
        if (wr == 0) PG8_BAR;
        E(acc, cur, wr, wc, fr, fq);
        if (!has_next) break;
#pragma unroll
        for (int a = 0; a < 2; ++a)
#pragma unroll
            for (int b = 0; b < 2; ++b)
#pragma unroll
                for (int m = 0; m < 4; ++m)
#pragma unroll
                    for (int n = 0; n < 2; ++n) acc[a][b][m][n] = (f32x4){0.f, 0.f, 0.f, 0.f};
        cur = nxt; cA = nA; cB = nB; ++ui;
        if (wr == 1) PG8_BAR;
    }
    PG8_WAIT_V(0);
    PG8_BAR;
#undef PG8_SA
#undef PG8_SB
#undef PG8_STAGE
#undef PG8_LDA
#undef PG8_LDB
#undef PG8_MMA
#undef PG8_WAIT_V
#undef PG8_WAIT_L
#undef PG8_BAR
#undef PG8_SCHED
}
}
using pg8::Unit;
typedef f32x4 Acc[2][2][4][2];

struct Sched1 {
    const char* H; const char* BT1; int G, c;
    __device__ __forceinline__ bool next(int i, Unit& u) const {
        const int L = i * G + c; constexpr int nM = 64, nN = 44, nwg = nM * nN;
        if (L >= nwg) return false;
        int wgid = L; { const int q = nwg / 8, r = nwg % 8, xcd = wgid % 8, off = wgid / 8; wgid = (xcd < r ? xcd * (q + 1) : r * (q + 1) + (xcd - r) * q) + off; }
        const int nig = 8 * nN, gid = wgid / nig, fm = gid * 8, gsz = (nM - fm) < 8 ? (nM - fm) : 8;
        const int pm = fm + ((wgid % nig) % gsz), pn = (wgid % nig) / gsz;
        u.pm = pm; u.pn = pn; u.nt = 32; u.kind = 0;
        u.a = H + (size_t)pm * 256 * LDH * 2; u.b = BT1 + (size_t)pn * 256 * DM * 2;
        return true;
    }
};
struct Sched1m {
    const char* H; const char* BT1; int e;
    __device__ __forceinline__ bool next(int i, Unit& u) const {
        if (i > 0 || e >= 64) return false;
        const int pm = 64 + (e & 7), pn = 44 + (e >> 3);
        u.pm = pm; u.pn = pn; u.nt = 32; u.kind = 0;
        u.a = H + (size_t)pm * 256 * LDH * 2; u.b = BT1 + (size_t)pn * 256 * DM * 2;
        return true;
    }
};
struct Epi1 {
    static constexpr bool HOOK = false;
    bf16_t* proj; bf16_t* mkv; float* kmp; const float* rope;
    __device__ __forceinline__ void hook(Acc&, const Unit&, int, int, int, int, int) const {}
    __device__ __forceinline__ void operator()(const Acc& acc, const Unit& u, int wr, int wc, int fr, int fq) const {
        const int pn = u.pn, pm = u.pm;
        int kind = 0, sh = 0; float sc = 1.f; bool kmean = false; bf16_t* base = proj; int ldc = LDP; int colt = pn * 256; int rowt = pm * 256;
        if (pm >= 64) { base = mkv; ldc = 2048; colt = (pn - 44) * 256; rowt = (pm - 64) * 256; }
        else if (pn < 4) { kind = 1; sc = QS128; }
        else if (pn < 8) { kind = 1; kmean = true; }
        else if (pn < 12) { kind = 0; }
        else if (pn < 16) { kind = 2; }
        else if (pn < 22) { kind = 1; sc = QS128; sh = 2 * ((pn - 16) >> 1); }
        else if (pn < 28) { kind = 1; sh = 2 * ((pn - 22) >> 1); }
        else if (pn < 34) { kind = 0; sh = 2 * ((pn - 28) >> 1); }
        else if (pn < 36) { kind = 2; }
        else if (pn < 40) { kind = 0; sc = QS256; }
        else { kind = 2; }
        const int sh_ = sh; const int ldc_ = ldc;
#define EPI1_STORE(ai, m, V00, V01, V10, V11) do { \
            int row = rowt + (ai) * 128 + wr * 64 + (m) * 16 + fr; \
            if (sh_) { const int b_ = row >> 11, p_ = row & 2047; row = (b_ << 11) + ((p_ & ((1 << sh_) - 1)) << (11 - sh_)) + (p_ >> sh_); } \
            bf16_t* rowp = base + (size_t)row * ldc_ + colt + wc * 32 + fq * 8; \
            u32x4 w_; w_.x = cvtpk(V00[0], V00[1]); w_.y = cvtpk(V00[2], V00[3]); w_.z = cvtpk(V01[0], V01[1]); w_.w = cvtpk(V01[2], V01[3]); __builtin_nontemporal_store(w_, (u32x4*)(rowp)); \
            w_.x = cvtpk(V10[0], V10[1]); w_.y = cvtpk(V10[2], V10[3]); w_.z = cvtpk(V11[0], V11[1]); w_.w = cvtpk(V11[2], V11[3]); __builtin_nontemporal_store(w_, (u32x4*)(rowp + 128)); } while (0)
        if (kind == 1) {
            f32x4 ksum[2][2];
#pragma unroll
            for (int bj = 0; bj < 2; ++bj)
#pragma unroll
                for (int n = 0; n < 2; ++n) ksum[bj][n] = (f32x4){0.f, 0.f, 0.f, 0.f};
            const int pos0 = (rowt + wr * 64 + fr) & (SEQ - 1), fo = (16 * wc + 4 * fq) * 2;
            const f32x4* rp0 = (const f32x4*)(rope + (size_t)pos0 * 128 + fo); const f32x4* rp16 = (const f32x4*)(rope + (size_t)16 * 128 + fo); const f32x4* rp128 = (const f32x4*)(rope + (size_t)128 * 128 + fo);
            const f32x4 a0 = rp0[0], a1 = rp0[1], b0 = rp16[0], b1 = rp16[1], d0 = rp128[0], d1 = rp128[1];
            const f32x4 c16 = {b0[0], b0[2], b1[0], b1[2]}, s16 = {b0[1], b0[3], b1[1], b1[3]}, c128 = {d0[0], d0[2], d1[0], d1[2]}, s128 = {d0[1], d0[3], d1[1], d1[3]};
            f32x4 cb = {a0[0], a0[2], a1[0], a1[2]}, sb = {a0[1], a0[3], a1[1], a1[3]};
#pragma unroll
            for (int ai = 0; ai < 2; ++ai) {
                f32x4 cs = cb, sn = sb;
#pragma unroll
                for (int m = 0; m < 4; ++m) {
                    f32x4 o[2][2];
#pragma unroll
                    for (int bj = 0; bj < 2; ++bj) {
                        const f32x4 x1 = acc[ai][bj][m][0], x2 = acc[ai][bj][m][1];
                        o[bj][0] = (x1 * cs - x2 * sn) * sc; o[bj][1] = (x2 * cs + x1 * sn) * sc;
                        ksum[bj][0] += o[bj][0]; ksum[bj][1] += o[bj][1];
                    }
                    EPI1_STORE(ai, m, o[0][0], o[0][1], o[1][0], o[1][1]);
                    const f32x4 cn = cs * c16 - sn * s16, sn2 = sn * c16 + cs * s16; cs = cn; sn = sn2;
                }
                const f32x4 cn = cb * c128 - sb * s128, sn2 = sb * c128 + cb * s128; cb = cn; sb = sn2;
            }
            if (kmean) {
#pragma unroll
                for (int bj = 0; bj < 2; ++bj)
#pragma unroll
                    for (int n = 0; n < 2; ++n) {
                        f32x4 s = ksum[bj][n];
#pragma unroll
                        for (int j = 0; j < 4; ++j) { float v = s[j]; v += __shfl_xor(v, 1); v += __shfl_xor(v, 2); v += __shfl_xor(v, 4); v += __shfl_xor(v, 8); s[j] = v; }
                        if (fr == 0) *(f32x4*)(kmp + ((size_t)pm * 2 + wr) * 1024 + (pn - 4) * 256 + bj * 128 + wc * 32 + fq * 8 + n * 4) = s;
                    }
            }
        } else if (kind == 2) {
#pragma unroll
            for (int ai = 0; ai < 2; ++ai)
#pragma unroll
                for (int m = 0; m < 4; ++m) {
                    f32x4 o[2][2];
#pragma unroll
                    for (int bj = 0; bj < 2; ++bj)
#pragma unroll
                        for (int n = 0; n < 2; ++n)
#pragma unroll
                            for (int j = 0; j < 4; ++j) { const float v = acc[ai][bj][m][n][j]; o[bj][n][j] = v * fast_sigmoid(v); }
                    EPI1_STORE(ai, m, o[0][0], o[0][1], o[1][0], o[1][1]);
                    asm volatile("" ::: "memory");
                }
        } else {
#pragma unroll
            for (int ai = 0; ai < 2; ++ai)
#pragma unroll
                for (int m = 0; m < 4; ++m) {
                    f32x4 o[2][2];
#pragma unroll
                    for (int bj = 0; bj < 2; ++bj)
#pragma unroll
                        for (int n = 0; n < 2; ++n) o[bj][n] = acc[ai][bj][m][n] * sc;
                    EPI1_STORE(ai, m, o[0][0], o[0][1], o[1][0], o[1][1]);
                    asm volatile("" ::: "memory");
                }
        }
#undef EPI1_STORE
    }
};

struct Sched3 {
    const char* H; const char* BTG; const char* Y; const char* WCAT; int G, vcu;
    __device__ __forceinline__ bool next(int i, Unit& u) const {
        const int k = i >> 2, s = i & 3, T = vcu + G * k;
        if (T >= 512) return false;
        const int pm = T >> 3, pn = T & 7;
        u.pm = pm; u.pn = pn; u.kind = s;
        if (s < 3) { u.nt = 32; u.a = H + (size_t)pm * 256 * LDH * 2; u.b = BTG + (size_t)(s * 2048 + pn * 256) * LDH * 2; }
        else { u.nt = 40; u.a = Y + (size_t)pm * 256 * LDH * 2; u.b = WCAT + (size_t)pn * 256 * LDH * 2; }
        return true;
    }
};
struct Epi3 {
    static constexpr bool HOOK = true;
    bf16_t* Gb; bf16_t* merged;
    __device__ __forceinline__ void hook(Acc& acc, const Unit& u, int t, int wr, int wc, int fr, int fq) const {
        if (u.kind != 3 || (t != 16 && t != 24)) return;
        const int from = (t == 16) ? 0 : 1;
        const bf16_t* gp = Gb + (size_t)(u.pm * 256 + wr * 64 + fr) * LDG + from * 2048 + u.pn * 256 + wc * 32 + fq * 8;
        u32x4 A[2][2], B[2][2];
        A[0][0] = *(const u32x4*)(gp); A[0][1] = *(const u32x4*)(gp + 128); B[0][0] = *(const u32x4*)(gp + 2048); B[0][1] = *(const u32x4*)(gp + 128 + 2048);
#pragma unroll
        for (int it = 0; it < 8; ++it) {
            const int ai = it >> 2, m = it & 3, cur = it & 1, nxt = cur ^ 1;
            gp += (m == 3 ? 80 : 16) * LDG;
            asm volatile("" : "+v"(gp) :: "memory");
            if (it < 7) { A[nxt][0] = *(const u32x4*)(gp); A[nxt][1] = *(const u32x4*)(gp + 128); B[nxt][0] = *(const u32x4*)(gp + 2048); B[nxt][1] = *(const u32x4*)(gp + 128 + 2048); }
#pragma unroll
            for (int bj = 0; bj < 2; ++bj) {
                const u32x4 a = A[cur][bj], b = B[cur][bj];
                f32x4 f0, f1;
                f0[0] = bflo(a.x) * __builtin_amdgcn_rcpf(bflo(b.x)); f0[1] = bfhi(a.x) * __builtin_amdgcn_rcpf(bfhi(b.x));
                f0[2] = bflo(a.y) * __builtin_amdgcn_rcpf(bflo(b.y)); f0[3] = bfhi(a.y) * __builtin_amdgcn_rcpf(bfhi(b.y));
                f1[0] = bflo(a.z) * __builtin_amdgcn_rcpf(bflo(b.z)); f1[1] = bfhi(a.z) * __builtin_amdgcn_rcpf(bfhi(b.z));
                f1[2] = bflo(a.w) * __builtin_amdgcn_rcpf(bflo(b.w)); f1[3] = bfhi(a.w) * __builtin_amdgcn_rcpf(bfhi(b.w));
                acc[ai][bj][m][0] *= f0; acc[ai][bj][m][1] *= f1;
            }
        }
    }
    __device__ __forceinline__ void operator()(const Acc& acc, const Unit& u, int wr, int wc, int fr, int fq) const {
        if (u.kind < 3) {
            bf16_t* gp = Gb + (size_t)(u.pm * 256 + wr * 64 + fr) * LDG + u.kind * 2048 + u.pn * 256 + wc * 32 + fq * 8;
#pragma unroll
            for (int ai = 0; ai < 2; ++ai)
#pragma unroll
                for (int m = 0; m < 4; ++m) {
                    asm volatile("" : "+v"(gp) :: "memory");
#pragma unroll
                    for (int bj = 0; bj < 2; ++bj) { const f32x4 v0 = acc[ai][bj][m][0], v1 = acc[ai][bj][m][1];
                        u32x4 w; w.x = cvtpk(gate_sigmoid(v0[0]), gate_sigmoid(v0[1])); w.y = cvtpk(gate_sigmoid(v0[2]), gate_sigmoid(v0[3]));
                        w.z = cvtpk(gate_sigmoid(v1[0]), gate_sigmoid(v1[1])); w.w = cvtpk(gate_sigmoid(v1[2]), gate_sigmoid(v1[3]));
                        *(u32x4*)(gp + bj * 128) = w; }
                    gp += (m == 3 ? 80 : 16) * LDG;
                }
        } else {
            const bf16_t* gp = Gb + (size_t)(u.pm * 256 + wr * 64 + fr) * LDG + 2 * 2048 + u.pn * 256 + wc * 32 + fq * 8;
            bf16_t* op = merged + (size_t)(u.pm * 256 + wr * 64 + fr) * DM + u.pn * 256 + wc * 32 + fq * 8;
            u32x4 Gv[2][2];
            Gv[0][0] = *(const u32x4*)(gp); Gv[0][1] = *(const u32x4*)(gp + 128);
#pragma unroll
            for (int it = 0; it < 8; ++it) {
                const int ai = it >> 2, m = it & 3, cur = it & 1, nxt = cur ^ 1;
                gp += (m == 3 ? 80 : 16) * LDG;
                asm volatile("" : "+v"(gp), "+v"(op) :: "memory");
                if (it < 7) { Gv[nxt][0] = *(const u32x4*)(gp); Gv[nxt][1] = *(const u32x4*)(gp + 128); }
#pragma unroll
                for (int bj = 0; bj < 2; ++bj) { const u32x4 g = Gv[cur][bj]; const f32x4 v0 = acc[ai][bj][m][0], v1 = acc[ai][bj][m][1];
                    u32x4 w; w.x = cvtpk(v0[0] * bflo(g.x), v0[1] * bfhi(g.x)); w.y = cvtpk(v0[2] * bflo(g.y), v0[3] * bfhi(g.y));
                    w.z = cvtpk(v1[0] * bflo(g.z), v1[1] * bfhi(g.z)); w.w = cvtpk(v1[2] * bflo(g.w), v1[3] * bfhi(g.w));
                    *(u32x4*)(op + bj * 128) = w; }
                op += (m == 3 ? 80 : 16) * DM;
            }
        }
    }
};

struct Sched4 {
    const char* A; const char* B; int G, vcu;
    __device__ __forceinline__ bool next(int i, Unit& u) const {
        const int T = vcu + G * i; if (T >= 512) return false;
        u.pm = T >> 3; u.pn = T & 7; u.nt = 32; u.kind = 0;
        u.a = A + (size_t)u.pm * 256 * DM * 2; u.b = B + (size_t)u.pn * 256 * DM * 2; return true;
    }
};
struct Epi4 {
    static constexpr bool HOOK = false;
    const float* x; float* out; float* ssq; unsigned* pcnt; const float* gfin;
    __device__ __forceinline__ void hook(Acc&, const Unit&, int, int, int, int, int) const {}
    __device__ __forceinline__ void operator()(Acc& acc, const Unit& u, int wr, int wc, int fr, int fq) const {
        const size_t off0 = (size_t)(u.pm * 256 + wr * 64 + fr) * DM + u.pn * 256 + wc * 32 + fq * 8;
        const float* xp = x + off0;
        float* sp = ssq + u.pm * 256 + wr * 64 + fr;
        f32x4 X[2][2][2];
#pragma unroll
        for (int bj = 0; bj < 2; ++bj)
#pragma unroll
            for (int n = 0; n < 2; ++n) X[0][bj][n] = *(const f32x4*)(xp + bj * 128 + n * 4);
#pragma unroll
        for (int it = 0; it < 8; ++it) {
            const int ai = it >> 2, m = it & 3, cur = it & 1, nxt = cur ^ 1;
            xp += (m == 3 ? 80 : 16) * DM;
            asm volatile("" : "+v"(xp) :: "memory");
            if (it < 7) {
#pragma unroll
                for (int bj = 0; bj < 2; ++bj)
#pragma unroll
                    for (int n = 0; n < 2; ++n) X[nxt][bj][n] = *(const f32x4*)(xp + bj * 128 + n * 4);
            }
            float s = 0.f;
#pragma unroll
            for (int bj = 0; bj < 2; ++bj)
#pragma unroll
                for (int n = 0; n < 2; ++n) {
                    const f32x4 o = X[cur][bj][n] + acc[ai][bj][m][n];
                    acc[ai][bj][m][n] = o;
                    s += (o[0] * o[0] + o[1] * o[1]) + (o[2] * o[2] + o[3] * o[3]);
                }
            s += __shfl_xor(s, 16); s += __shfl_xor(s, 32);
            if (fq == 0) (void)__hip_atomic_fetch_add(sp + ai * 128 + m * 16, s, __ATOMIC_RELAXED, __HIP_MEMORY_SCOPE_AGENT);
        }
        asm volatile("s_waitcnt vmcnt(0)" ::: "memory");
        unsigned* pc = pcnt + 64 * u.pm;
        if (fq == 0 && fr == 0) (void)__hip_atomic_fetch_add(pc, 1u, __ATOMIC_RELAXED, __HIP_MEMORY_SCOPE_AGENT);
        float* op = out + off0;
        const float* gp = gfin + u.pn * 256 + wc * 32 + fq * 8;
        f32x4 gv[2][2];
#pragma unroll
        for (int bj = 0; bj < 2; ++bj)
#pragma unroll
            for (int n = 0; n < 2; ++n) gv[bj][n] = *(const f32x4*)(gp + bj * 128 + n * 4);
        { unsigned spin = 0; while (__hip_atomic_load(pc, __ATOMIC_RELAXED, __HIP_MEMORY_SCOPE_AGENT) < 64u) { __builtin_amdgcn_s_sleep(1); if (++spin > (1u << 20)) break; } }
        asm volatile("" ::: "memory");
        float tot[8];
#pragma unroll
        for (int it = 0; it < 8; ++it) tot[it] = __hip_atomic_load(sp + (it >> 2) * 128 + (it & 3) * 16, __ATOMIC_RELAXED, __HIP_MEMORY_SCOPE_AGENT);
#pragma unroll
        for (int it = 0; it < 8; ++it) {
            const int ai = it >> 2, m = it & 3;
            const float rs = 1.0f / sqrtf(tot[it] * (1.0f / DM) + 1e-6f);
#pragma unroll
            for (int bj = 0; bj < 2; ++bj)
#pragma unroll
                for (int n = 0; n < 2; ++n) *(f32x4*)(op + bj * 128 + n * 4) = acc[ai][bj][m][n] * rs * gv[bj][n];
            op += (m == 3 ? 80 : 16) * DM;
            asm volatile("" : "+v"(op));
        }
    }
};

struct AttnC { const bf16_t* proj; const bf16_t* mkv; const float* kmp; bf16_t* Y; bf16_t* OB; float* LSE; };
__device__ __forceinline__ int crow(int r, int hi) { return (r & 3) + 8 * (r >> 2) + 4 * hi; }

template <int DQK, int MODE>
__device__ __forceinline__ void attn_unit(LAS unsigned char* lds, const AttnC& C, const int p0, const int p1, const int p2, const int p3) {
    int tid_ = threadIdx.x; asm volatile("" : "+v"(tid_));
    const int tid = tid_, lane = tid & 63, wid = __builtin_amdgcn_readfirstlane(tid >> 6), r32 = lane & 31, hi = lane >> 5;
    constexpr int KP = DQK * 2 + 16, NQ = DQK / 16, KCH = DQK / 8, KPT = 64 * KCH / 512;
    LAS unsigned char* Ks = lds; LAS unsigned char* Vt = lds + 36864; LAS float* km = (LAS float*)(lds + 131072);
    const bf16_t *Qb, *Kb, *Vb; int ldk, NT, t0 = 0;
    if (MODE == 0) { const size_t rb = (size_t)p0 * SEQ; Qb = C.proj + (rb + p2 * 256) * LDP + C_QA + p1 * 128; Kb = C.proj + rb * LDP + C_KA + p1 * 128; Vb = C.proj + rb * LDP + C_VA + p1 * 128; ldk = LDP; NT = 4 * (p2 + 1); }
    else if (MODE == 1) { const size_t rb = (size_t)p1 * SEQ; const int hd = 4 * p0 + p2; Qb = C.proj + (rb + p3 * 256) * LDP + C_QB + hd * 128; Kb = C.proj + rb * LDP + C_KB + hd * 128; Vb = C.proj + rb * LDP + C_VB + hd * 128;
        ldk = LDP; { const int lg = 11 - 2 * p0, rs = ((256 * p3) >> lg) << (lg - 6); t0 = (4 * p3 - 2) > rs ? (4 * p3 - 2) : rs; }
        NT = 4 * p3 + 4 - t0; }
    else { Qb = C.proj + ((size_t)p0 * SEQ + p2 * 256) * LDP + C_QM + p1 * 256; Kb = C.mkv + (size_t)p0 * MEML * 2048 + p1 * 256; Vb = C.mkv + (size_t)p0 * MEML * 2048 + 1024 + p1 * 256 + p3 * 128; ldk = 2048; NT = 4; }
    bf16x8 qr[NQ];
    { const bf16_t* qrow = Qb + (size_t)(32 * wid + r32) * LDP + 8 * hi;
#pragma unroll
      for (int d0 = 0; d0 < NQ; ++d0) qr[d0] = *(const bf16x8*)(qrow + 16 * d0); }
    LAS unsigned char* const stg = lds + 65536 + wid * 8192;
    if (MODE != 1) {
        const size_t tokz = (size_t)p0 * SEQ + p2 * 256 + 32 * wid;
        const bf16_t* zsrc = (MODE == 0) ? C.proj + tokz * LDP + C_ZA + p1 * 128 : C.proj + tokz * LDP + C_ZM + p1 * 256 + p3 * 128;
#pragma unroll
        for (int i = 0; i < 8; ++i) { const int row = 4 * i + (lane >> 4), ch = (lane & 15) ^ (row & 15);
            __builtin_amdgcn_global_load_lds((const unsigned*)(zsrc + (size_t)row * LDP + ch * 8), (LAS unsigned*)(stg + i * 1024), 16, 0, 0); }
    }
    u32x4 kreg[KPT], vreg0, vreg1;
    const int vpr = ((wid >> 1) << 3) + (lane >> 3), vdc = ((wid & 1) << 3) + (lane & 7);
    auto krow = [&](int t) -> int { if (MODE == 0) return t < 4 ? p2 * 256 + 64 * t : 64 * (t - 4); else return 64 * (t0 + t); };
    auto load_tile = [&](int t) {
        const size_t r0 = (size_t)krow(t);
#pragma unroll
        for (int i = 0; i < KPT; ++i) { const int c = tid + 512 * i, row = c / KCH, ch = c % KCH; kreg[i] = *(const u32x4*)(Kb + (r0 + row) * ldk + ch * 8); }
        vreg0 = *(const u32x4*)(Vb + (r0 + 2 * vpr) * ldk + vdc * 8); vreg1 = *(const u32x4*)(Vb + (r0 + 2 * vpr + 1) * ldk + vdc * 8);
    };
    constexpr bool PREF = false;
    auto dma_tile = [&](int t, int buf) {
        const size_t r0 = (size_t)krow(t);
#pragma unroll
        for (int i = 0; i < 2; ++i) {
            const int j = 2 * wid + i, row = 4 * j + (lane >> 4), pos = lane & 15;
            const int chk = pos ^ (row & 15), chv = pos ^ (((row & 3) << 2) | ((row >> 2) & 3));
            __builtin_amdgcn_global_load_lds((const unsigned*)(Kb + (r0 + row) * ldk + chk * 8), (LAS unsigned*)(lds + buf * 16384 + j * 1024), 16, 0, 0);
            __builtin_amdgcn_global_load_lds((const unsigned*)(Vb + (r0 + row) * ldk + chv * 8), (LAS unsigned*)(lds + 32768 + buf * 16384 + j * 1024), 16, 0, 0);
        }
    };
    if (DQK == 128) dma_tile(0, 0);
    unsigned sel = 0;
    if (MODE == 0) {
        const int qb = p2;
        for (int e = tid; e < qb * 128; e += 512) { const int n = e >> 7, d = e & 127; const float* kp = C.kmp + ((size_t)(p0 * 8 + n) * 2) * 1024 + p1 * 128 + d; km[e] = (kp[0] + kp[1024]) * (1.0f / 256.0f); }
        __syncthreads();
        if (qb <= 3) sel = (1u << qb) - 1u;
        else {
            float v1 = -INFINITY, v2 = -INFINITY, v3 = -INFINITY; int i1 = 0, i2 = 0, i3 = 0;
#pragma unroll 1
            for (int n = 0; n < qb; ++n) {
                float s = 0.f;
#pragma unroll
                for (int d0 = 0; d0 < NQ; ++d0) {
                    const f32x4 k0 = *(const LAS f32x4*)(km + n * 128 + 16 * d0 + 8 * hi), k1 = *(const LAS f32x4*)(km + n * 128 + 16 * d0 + 8 * hi + 4);
                    const u32x4 qw = __builtin_bit_cast(u32x4, qr[d0]);
                    s += bflo(qw.x) * k0[0] + bfhi(qw.x) * k0[1] + bflo(qw.y) * k0[2] + bfhi(qw.y) * k0[3] + bflo(qw.z) * k1[0] + bfhi(qw.z) * k1[1] + bflo(qw.w) * k1[2] + bfhi(qw.w) * k1[3];
                }
                { auto rr = __builtin_amdgcn_permlane32_swap(__float_as_uint(s), __float_as_uint(s), false, false); s = __uint_as_float(rr[0]) + __uint_as_float(rr[1]); }
                const bool g1 = s > v1, g2 = s > v2, g3 = s > v3;
                v3 = g2 ? v2 : (g3 ? s : v3); i3 = g2 ? i2 : (g3 ? n : i3);
                v2 = g1 ? v1 : (g2 ? s : v2); i2 = g1 ? i1 : (g2 ? n : i2);
                v1 = g1 ? s : v1; i1 = g1 ? n : i1;
            }
            sel = (1u << i1) | (1u << i2) | (1u << i3);
        }
    }
    const int lgL = (MODE == 1) ? (11 - 2 * p0) : 0;
    float m_run = NEGBIG, l_run = 0.f;
    f32x16 o[4];
#pragma unroll
    for (int i = 0; i < 4; ++i)
#pragma unroll
        for (int r = 0; r < 16; ++r) o[i][r] = 0.f;
    const int qpos = 32 * wid + r32;
    if constexpr (DQK == 128) {
    for (int t = 0; t < NT; ++t) {
        asm volatile("s_waitcnt vmcnt(0)" ::: "memory");
        __syncthreads();
        if (t + 1 < NT) dma_tile(t + 1, (t + 1) & 1);
        LAS unsigned char* const Kt = lds + (t & 1) * 16384; LAS unsigned char* const Vi = lds + 32768 + (t & 1) * 16384;
        bool skip = false; bool lanevalid = true;
        if (MODE == 0) { if (t < 4) skip = (64 * t > 32 * wid + 31); else { lanevalid = (sel >> ((t - 4) >> 2)) & 1u; skip = !__any(lanevalid); } }
        if (MODE == 1) { const int ks = 64 * (t0 + t), vq0 = 256 * p3 + 32 * wid; skip = (ks > vq0 + 31) || (ks + 63 < vq0 - 128) || ((ks >> lgL) != (vq0 >> lgL)); }
        if (skip) continue;
        const float sinit = (MODE == 0 && !lanevalid) ? NEGBIG : 0.f;
        f32x16 s0, s1;
#pragma unroll
        for (int r = 0; r < 16; ++r) { s0[r] = sinit; s1[r] = sinit; }
#pragma unroll
        for (int d0 = 0; d0 < NQ; ++d0) {
            const bf16x8 k0 = *(const LAS bf16x8*)(Kt + r32 * 256 + (((2 * d0 + hi) ^ (r32 & 15)) << 4));
            const bf16x8 k1 = *(const LAS bf16x8*)(Kt + (r32 + 32) * 256 + (((2 * d0 + hi) ^ (r32 & 15)) << 4));
            s0 = __builtin_amdgcn_mfma_f32_32x32x16_bf16(k0, qr[d0], s0, 0, 0, 0);
            s1 = __builtin_amdgcn_mfma_f32_32x32x16_bf16(k1, qr[d0], s1, 0, 0, 0);
        }
        if (MODE == 0) {
            if (t < 4) {
#pragma unroll
                for (int r = 0; r < 16; ++r) { const int kv = 64 * t + crow(r, hi); if (kv > qpos) s0[r] = NEGBIG; if (kv + 32 > qpos) s1[r] = NEGBIG; }
            }
        }
        if (MODE == 1) {
            const int vq = 256 * p3 + qpos, ks = 64 * (t0 + t);
#pragma unroll
            for (int r = 0; r < 16; ++r) {
                const int vk = ks + crow(r, hi); const int dl0 = vq - vk, dl1 = dl0 - 32;
                if (!(dl0 >= 0 && dl0 <= 128 && ((vk >> lgL) == (vq >> lgL)))) s0[r] = NEGBIG;
                if (!(dl1 >= 0 && dl1 <= 128 && (((vk + 32) >> lgL) == (vq >> lgL)))) s1[r] = NEGBIG;
            }
        }
        __builtin_amdgcn_s_setprio(1);
        float mx = s0[0];
#pragma unroll
        for (int r = 1; r < 16; ++r) mx = fmaxf(mx, s0[r]);
#pragma unroll
        for (int r = 0; r < 16; ++r) mx = fmaxf(mx, s1[r]);
        { auto rr = __builtin_amdgcn_permlane32_swap(__float_as_uint(mx), __float_as_uint(mx), false, false); mx = fmaxf(__uint_as_float(rr[0]), __uint_as_float(rr[1])); }
        const float mn = fmaxf(m_run, mx), alpha = __builtin_amdgcn_exp2f(m_run - mn);
        m_run = mn;
        float ls = 0.f;
#pragma unroll
        for (int r = 0; r < 16; ++r) { s0[r] = __builtin_amdgcn_exp2f(s0[r] - mn); s1[r] = __builtin_amdgcn_exp2f(s1[r] - mn); ls += s0[r] + s1[r]; }
        l_run = l_run * alpha + ls;
        if (__any(alpha != 1.0f)) {
#pragma unroll
        for (int i = 0; i < 4; ++i)
#pragma unroll
            for (int r = 0; r < 16; ++r) o[i][r] *= alpha;
        }
        __builtin_amdgcn_s_setprio(0);
        bf16x8 pa[4];
        { u32x4 w;
          w.x = cvtpk(s0[0], s0[1]); w.y = cvtpk(s0[2], s0[3]); w.z = cvtpk(s0[4], s0[5]); w.w = cvtpk(s0[6], s0[7]); pa[0] = __builtin_bit_cast(bf16x8, w);
          w.x = cvtpk(s0[8], s0[9]); w.y = cvtpk(s0[10], s0[11]); w.z = cvtpk(s0[12], s0[13]); w.w = cvtpk(s0[14], s0[15]); pa[1] = __builtin_bit_cast(bf16x8, w);
          w.x = cvtpk(s1[0], s1[1]); w.y = cvtpk(s1[2], s1[3]); w.z = cvtpk(s1[4], s1[5]); w.w = cvtpk(s1[6], s1[7]); pa[2] = __builtin_bit_cast(bf16x8, w);
          w.x = cvtpk(s1[8], s1[9]); w.y = cvtpk(s1[10], s1[11]); w.z = cvtpk(s1[12], s1[13]); w.w = cvtpk(s1[14], s1[15]); pa[3] = __builtin_bit_cast(bf16x8, w); }
#pragma unroll
        for (int db = 0; db < 4; ++db) {
#pragma unroll
            for (int ks = 0; ks < 4; ++ks) {
                const int tq = (lane & 15) >> 2, tp = lane & 3, tblk = (lane >> 4) & 1, tch = 4 * db + 2 * tblk + (tp >> 1);
                const int row0 = 16 * ks + 4 * hi + tq, row1 = row0 + 8;
                const v4i16_t lo = __builtin_amdgcn_ds_read_tr16_b64_v4i16((LAS v4i16_t*)(Vi + row0 * 256 + ((tch ^ (((row0 & 3) << 2) | ((row0 >> 2) & 3))) << 4) + 8 * (tp & 1)));
                const v4i16_t hi4 = __builtin_amdgcn_ds_read_tr16_b64_v4i16((LAS v4i16_t*)(Vi + row1 * 256 + ((tch ^ (((row1 & 3) << 2) | ((row1 >> 2) & 3))) << 4) + 8 * (tp & 1)));
                const bf16x8 va = (bf16x8){lo[0], lo[1], lo[2], lo[3], hi4[0], hi4[1], hi4[2], hi4[3]};
                o[db] = __builtin_amdgcn_mfma_f32_32x32x16_bf16(va, pa[ks], o[db], 0, 0, 0);
            }
        }
    }
    } else {
    for (int t = 0; t < NT; ++t) {
        load_tile(t);
        __syncthreads();
#pragma unroll
        for (int i = 0; i < KPT; ++i) { const int c = tid + 512 * i, row = c / KCH, ch = c % KCH; *(LAS u32x4*)(Ks + row * KP + ch * 16) = kreg[i]; }
        { const int kv = 2 * vpr, pos = (kv & ~12) | ((kv & 4) << 1) | ((kv & 8) >> 1);
          const unsigned a[4] = {vreg0.x, vreg0.y, vreg0.z, vreg0.w}, b[4] = {vreg1.x, vreg1.y, vreg1.z, vreg1.w};
#pragma unroll
          for (int e2 = 0; e2 < 4; ++e2) {
              const int d = vdc * 8 + 2 * e2;
              const unsigned w0 = (a[e2] & 0xffffu) | (b[e2] << 16), w1 = (a[e2] >> 16) | (b[e2] & 0xffff0000u);
              *(LAS unsigned*)(Vt + d * 144 + ((((pos >> 3) ^ (vdc & 7)) << 4) | ((pos & 7) << 1))) = w0;
              *(LAS unsigned*)(Vt + (d + 1) * 144 + ((((pos >> 3) ^ (vdc & 7)) << 4) | ((pos & 7) << 1))) = w1;
          } }
        __syncthreads();
        bool skip = false; bool lanevalid = true;
        if (MODE == 0) { if (t < 4) skip = (64 * t > 32 * wid + 31); else { lanevalid = (sel >> ((t - 4) >> 2)) & 1u; skip = !__any(lanevalid); } }
        if (MODE == 1) { const int ks = 64 * (t0 + t), vq0 = 256 * p3 + 32 * wid; skip = (ks > vq0 + 31) || (ks + 63 < vq0 - 128) || ((ks >> lgL) != (vq0 >> lgL)); }
        if (skip) continue;
        const float sinit = (MODE == 0 && !lanevalid) ? NEGBIG : 0.f;
        f32x16 s0, s1;
#pragma unroll
        for (int r = 0; r < 16; ++r) { s0[r] = sinit; s1[r] = sinit; }
#pragma unroll
        for (int d0 = 0; d0 < NQ; ++d0) {
            const bf16x8 k0 = *(const LAS bf16x8*)(Ks + r32 * KP + d0 * 32 + hi * 16);
            const bf16x8 k1 = *(const LAS bf16x8*)(Ks + (r32 + 32) * KP + d0 * 32 + hi * 16);
            s0 = __builtin_amdgcn_mfma_f32_32x32x16_bf16(k0, qr[d0], s0, 0, 0, 0);
            s1 = __builtin_amdgcn_mfma_f32_32x32x16_bf16(k1, qr[d0], s1, 0, 0, 0);
        }
        if (MODE == 0) {
            if (t < 4) {
#pragma unroll
                for (int r = 0; r < 16; ++r) { const int kv = 64 * t + crow(r, hi); if (kv > qpos) s0[r] = NEGBIG; if (kv + 32 > qpos) s1[r] = NEGBIG; }
            }
        }
        if (MODE == 1) {
            const int vq = 256 * p3 + qpos, ks = 64 * (t0 + t);
#pragma unroll
            for (int r = 0; r < 16; ++r) {
                const int vk = ks + crow(r, hi); const int dl0 = vq - vk, dl1 = dl0 - 32;
                if (!(dl0 >= 0 && dl0 <= 128 && ((vk >> lgL) == (vq >> lgL)))) s0[r] = NEGBIG;
                if (!(dl1 >= 0 && dl1 <= 128 && (((vk + 32) >> lgL) == (vq >> lgL)))) s1[r] = NEGBIG;
            }
        }
        float mx = s0[0];
#pragma unroll
        for (int r = 1; r < 16; ++r) mx = fmaxf(mx, s0[r]);
#pragma unroll
        for (int r = 0; r < 16; ++r) mx = fmaxf(mx, s1[r]);
        { auto rr = __builtin_amdgcn_permlane32_swap(__float_as_uint(mx), __float_as_uint(mx), false, false); mx = fmaxf(__uint_as_float(rr[0]), __uint_as_float(rr[1])); }
        const float mn = fmaxf(m_run, mx), alpha = __builtin_amdgcn_exp2f(m_run - mn);
        m_run = mn;
        float ls = 0.f;
#pragma unroll
        for (int r = 0; r < 16; ++r) { s0[r] = __builtin_amdgcn_exp2f(s0[r] - mn); s1[r] = __builtin_amdgcn_exp2f(s1[r] - mn); ls += s0[r] + s1[r]; }
        l_run = l_run * alpha + ls;
        if (__any(alpha != 1.0f)) {
#pragma unroll
        for (int i = 0; i < 4; ++i)
#pragma unroll
            for (int r = 0; r < 16; ++r) o[i][r] *= alpha;
        }
        bf16x8 pa[4];
        { u32x4 w;
          w.x = cvtpk(s0[0], s0[1]); w.y = cvtpk(s0[2], s0[3]); w.z = cvtpk(s0[4], s0[5]); w.w = cvtpk(s0[6], s0[7]); pa[0] = __builtin_bit_cast(bf16x8, w);
          w.x = cvtpk(s0[8], s0[9]); w.y = cvtpk(s0[10], s0[11]); w.z = cvtpk(s0[12], s0[13]); w.w = cvtpk(s0[14], s0[15]); pa[1] = __builtin_bit_cast(bf16x8, w);
          w.x = cvtpk(s1[0], s1[1]); w.y = cvtpk(s1[2], s1[3]); w.z = cvtpk(s1[4], s1[5]); w.w = cvtpk(s1[6], s1[7]); pa[2] = __builtin_bit_cast(bf16x8, w);
          w.x = cvtpk(s1[8], s1[9]); w.y = cvtpk(s1[10], s1[11]); w.z = cvtpk(s1[12], s1[13]); w.w = cvtpk(s1[14], s1[15]); pa[3] = __builtin_bit_cast(bf16x8, w); }
#pragma unroll
        for (int db = 0; db < 4; ++db) {
            const int d = 32 * db + r32;
#pragma unroll
            for (int ks = 0; ks < 4; ++ks) {
                const bf16x8 va = *(const LAS bf16x8*)(Vt + d * 144 + (((2 * ks + hi) ^ ((d >> 3) & 7)) << 4));
                o[db] = __builtin_amdgcn_mfma_f32_32x32x16_bf16(va, pa[ks], o[db], 0, 0, 0);
            }
        }
    }
    }
    { auto rr = __builtin_amdgcn_permlane32_swap(__float_as_uint(l_run), __float_as_uint(l_run), false, false); l_run = __uint_as_float(rr[0]) + __uint_as_float(rr[1]); }
    const float rl = 1.0f / l_run;
    asm volatile("s_waitcnt vmcnt(0)" ::: "memory");
#pragma unroll
    for (int db = 0; db < 4; ++db)
#pragma unroll
        for (int a = 0; a < 4; ++a) {
            LAS u32x2* sp = (LAS u32x2*)(stg + r32 * 256 + (((4 * db + a) ^ (r32 & 15)) << 4) + hi * 8);
            u32x2 w;
            if (MODE == 1) { w.x = cvtpk(o[db][4 * a] * rl, o[db][4 * a + 1] * rl); w.y = cvtpk(o[db][4 * a + 2] * rl, o[db][4 * a + 3] * rl); }
            else { const u32x2 z = *sp; w.x = cvtpk(o[db][4 * a] * rl * bflo(z.x), o[db][4 * a + 1] * rl * bfhi(z.x)); w.y = cvtpk(o[db][4 * a + 2] * rl * bflo(z.y), o[db][4 * a + 3] * rl * bfhi(z.y)); }
            *sp = w;
        }
    asm volatile("s_waitcnt lgkmcnt(0)" ::: "memory");
    const int erow = lane >> 4, epos = lane & 15;
    if (MODE == 1) {
        const int g = p0, sh = 2 * g;
#pragma unroll
        for (int i = 0; i < 8; ++i) {
            const int row = 4 * i + erow, v = 256 * p3 + 32 * wid + row, res = v >> lgL, ii = v & ((1 << lgL) - 1), p = (ii << sh) + res;
            const size_t tok = (size_t)p1 * SEQ + p;
            const u32x4 ov = *(const LAS u32x4*)(stg + row * 256 + epos * 16);
            *(u32x4*)(C.OB + ((size_t)g * MTOK + tok) * 512 + p2 * 128 + ((epos ^ (row & 15)) << 3)) = ov;
        }
        { const int v = 256 * p3 + qpos, res = v >> lgL, ii = v & ((1 << lgL) - 1), p = (ii << sh) + res; const size_t tok = (size_t)p1 * SEQ + p;
          if (hi == 0) C.LSE[((size_t)g * MTOK + tok) * 4 + p2] = m_run + __builtin_amdgcn_logf(l_run); }
    } else {
        const size_t tok0 = (size_t)p0 * SEQ + p2 * 256 + 32 * wid;
        bf16_t* yp = (MODE == 0) ? C.Y + tok0 * LDH + p1 * 128 : C.Y + tok0 * LDH + 1536 + p1 * 256 + p3 * 128;
#pragma unroll
        for (int i = 0; i < 8; ++i) {
            const int row = 4 * i + erow;
            const u32x4 ov = *(const LAS u32x4*)(stg + row * 256 + epos * 16);
            *(u32x4*)(yp + (size_t)row * LDH + ((epos ^ (row & 15)) << 3)) = ov;
        }
    }
    asm volatile("s_waitcnt lgkmcnt(0)" ::: "memory");
}

constexpr int N_ATT_ITEMS = 1792;
__device__ __forceinline__ void attn_phase(LAS unsigned char* lds, const AttnC& C, unsigned* counter, unsigned* mkv_cnt) {
    LAS int* wq = (LAS int*)(lds + 139264);
    bool mkv_ready = false;
    int nxt_idx = 0;
    if (threadIdx.x == 0) nxt_idx = (int)atomicAdd(counter, 1u);
    for (;;) {
        __syncthreads();
        if (threadIdx.x == 0) wq[0] = nxt_idx;
        __syncthreads();
        int idx = wq[0];
        if (idx >= N_ATT_ITEMS) break;
        if (threadIdx.x == 0) nxt_idx = (int)atomicAdd(counter, 1u);
        if (idx < 192) { attn_unit<128, 0>(lds, C, (idx & 63) >> 3, idx & 7, 7 - (idx >> 6), 0); continue; } idx -= 192;
        if (idx < 192) { attn_unit<128, 0>(lds, C, (idx & 63) >> 3, idx & 7, 4 - (idx >> 6), 0); continue; } idx -= 192;
        if (idx < 768) { attn_unit<128, 1>(lds, C, idx >> 8, (idx >> 5) & 7, (idx >> 3) & 3, idx & 7); continue; } idx -= 768;
        if (idx < 512) {
            if (!mkv_ready) {
                if (threadIdx.x == 0) {
                    unsigned spin = 0;
                    while (__hip_atomic_load(mkv_cnt, __ATOMIC_RELAXED, __HIP_MEMORY_SCOPE_AGENT) < 64u) { __builtin_amdgcn_s_sleep(2); if (++spin > (1u << 22)) break; }
                    __builtin_amdgcn_fence(__ATOMIC_ACQUIRE, "agent");
                    asm volatile("s_waitcnt vmcnt(0)" ::: "memory");
                }
                __syncthreads();
                mkv_ready = true;
            }
            attn_unit<256, 2>(lds, C, idx >> 6, (idx >> 4) & 3, (idx >> 1) & 7, idx & 1); continue;
        } idx -= 512;
        attn_unit<128, 0>(lds, C, (idx & 63) >> 3, idx & 7, 1 - (idx >> 6), 0);
    }
}

__device__ __forceinline__ int srccol_in(int v) {
    const int pn = v >> 8; const bool rp = (pn < 8) || (pn >= 16 && pn < 28);
    if (!rp) return v;
    const int dp = v & 127; const int d = ((dp >> 2) & 1) * 64 + (dp >> 5) * 16 + ((dp >> 3) & 3) * 4 + (dp & 3);
    return (v & ~127) + d;
}
template <bool PERMC, bool NTS = false>
__device__ __forceinline__ void transpose_item(const float* W, int Nsrc, int col_off, bf16_t* WT, int ldt, int row_off, int koff, int nblk, LAS float* scr, int item, int lane) {
    const int kb = item / nblk, nb = item % nblk, k0 = 64 * kb, n0 = 32 * nb;
    const int vcol = n0 + (lane & 31); const int sc = col_off + (PERMC ? srccol_in(vcol) : vcol);
#pragma unroll 8
    for (int i = 0; i < 32; ++i) { const int kk = 2 * i + (lane >> 5); scr[kk * 33 + (lane & 31)] = __builtin_nontemporal_load(W + (size_t)(k0 + kk) * Nsrc + sc); }
    asm volatile("s_waitcnt lgkmcnt(0)" ::: "memory");
    const int c = lane & 7;
#pragma unroll
    for (int j = 0; j < 4; ++j) { const int n = (lane >> 3) + 8 * j; const LAS float* s = scr + (8 * c) * 33 + n;
        u32x4 o; o.x = cvtpk(s[0 * 33], s[1 * 33]); o.y = cvtpk(s[2 * 33], s[3 * 33]); o.z = cvtpk(s[4 * 33], s[5 * 33]); o.w = cvtpk(s[6 * 33], s[7 * 33]);
        if (NTS) __builtin_nontemporal_store(o, (u32x4*)(WT + (size_t)(row_off + n0 + n) * ldt + koff + k0 + 8 * c)); else *(u32x4*)(WT + (size_t)(row_off + n0 + n) * ldt + koff + k0 + 8 * c) = o; }
    asm volatile("s_waitcnt lgkmcnt(0)" ::: "memory");
}
__device__ __forceinline__ void rms_row(const float* xrow, const float* g, bf16_t* orow, int lane) {
    const f32x4* xr = (const f32x4*)xrow + lane; const f32x4* gr = (const f32x4*)g + lane;
    f32x4 v[8]; float s = 0.f;
#pragma unroll
    for (int j = 0; j < 8; ++j) { v[j] = __builtin_nontemporal_load(xr + 64 * j); s += (v[j][0] * v[j][0] + v[j][1] * v[j][1]) + (v[j][2] * v[j][2] + v[j][3] * v[j][3]); }
    const float rs = 1.0f / sqrtf(wave_sum(s) * (1.0f / DM) + 1e-6f);
    u32x2* o8 = (u32x2*)orow + lane;
#pragma unroll
    for (int j = 0; j < 8; ++j) { const f32x4 gv = gr[64 * j]; u32x2 w; w.x = cvtpk(v[j][0] * rs * gv[0], v[j][1] * rs * gv[1]); w.y = cvtpk(v[j][2] * rs * gv[2], v[j][3] * rs * gv[3]); o8[64 * j] = w; }
}

#define XB_TMO      128
#define XB_XCNT(j)  (256  + 64 * (j))
#define XB_XSUB(j)  (1280 + 64 * (j))
#define XB_XGEN(j)  (2304 + 64 * (j))
#define XB_TOP      3328
#define XB_TOPGEN   3392
#define XCD_BAR_WORDS 3456
#define XB_SPIN_CAP (1u << 18)
__device__ __forceinline__ unsigned xb_ld(unsigned* p)              { return __hip_atomic_load(p, __ATOMIC_RELAXED, __HIP_MEMORY_SCOPE_AGENT); }
__device__ __forceinline__ unsigned xb_add(unsigned* p, unsigned v) { return __hip_atomic_fetch_add(p, v, __ATOMIC_RELAXED, __HIP_MEMORY_SCOPE_AGENT); }
__device__ __forceinline__ unsigned xb_xcc_id() { return (unsigned)__builtin_amdgcn_s_getreg((3 << 11) | 20) & 0xFu; }
#define XB_SPIN(cond, bar) do { unsigned _sp = 0; while (cond) { __builtin_amdgcn_s_sleep(1); \
    if ((++_sp & 255u) == 0u) { if (xb_ld(&(bar)[XB_TMO])) break; if (_sp > XB_SPIN_CAP) { atomicAdd(&(bar)[XB_TMO], 1u); break; } } } } while (0)
struct XcdBarrier { unsigned* bar; unsigned x; volatile LAS unsigned* st; };
__device__ __forceinline__ XcdBarrier xcd_barrier_post(unsigned* bar, volatile LAS unsigned* st) {
    XcdBarrier b; b.bar = bar; b.x = xb_xcc_id(); b.st = st;
    if (threadIdx.x == 0) (void)xb_add(&bar[XB_XCNT(b.x)], 1u);
    return b;
}
__device__ __forceinline__ void xcd_barrier_complete(unsigned* bar, unsigned x, unsigned& nloc, unsigned& nx) {
    const unsigned G = gridDim.x * gridDim.y * gridDim.z;
    unsigned sum, cnt, mine, sp = 0u;
    for (;;) {
        sum = 0u; cnt = 0u; mine = 0u;
#pragma unroll
        for (unsigned j = 0; j < 16; ++j) { const unsigned c = xb_ld(&bar[XB_XCNT(j)]); sum += c; cnt += (c > 0u) ? 1u : 0u; mine = (j == x) ? c : mine; }
        if (sum == G) break;
        __builtin_amdgcn_s_sleep(1);
        if ((++sp & 255u) == 0u) { if (xb_ld(&bar[XB_TMO])) break; if (sp > XB_SPIN_CAP) { atomicAdd(&bar[XB_TMO], 1u); break; } }
    }
    nloc = mine > 0u ? mine : 1u; nx = cnt > 0u ? cnt : 1u;
}
__device__ __forceinline__ void xcd_barrier(const XcdBarrier& b) {
    asm volatile("s_waitcnt vmcnt(0)" ::: "memory");
    __syncthreads();
    if (threadIdx.x == 0) {
        unsigned* bar = b.bar;
        __builtin_amdgcn_s_waitcnt(0);
        unsigned nloc = b.st[0], nx = b.st[1];
        if (nloc == 0u) { xcd_barrier_complete(bar, b.x, nloc, nx); b.st[0] = nloc; b.st[1] = nx; }
        const unsigned old = xb_add(&bar[XB_XSUB(b.x)], 1u);
        const unsigned gen = old / nloc;
        if (old + 1u == (gen + 1u) * nloc) {
            __builtin_amdgcn_fence(__ATOMIC_RELEASE, "agent");
            asm volatile("s_waitcnt vmcnt(0)" ::: "memory");
            const unsigned og = xb_add(&bar[XB_TOP], 1u);
            const unsigned tg = og / nx;
            if (og + 1u == (tg + 1u) * nx) xb_add(&bar[XB_TOPGEN], 1u);
            else XB_SPIN(xb_ld(&bar[XB_TOPGEN]) == tg, bar);
            __builtin_amdgcn_fence(__ATOMIC_ACQUIRE, "agent");
            xb_add(&bar[XB_XGEN(b.x)], 1u);
            asm volatile("s_waitcnt vmcnt(0)" ::: "memory");
        } else {
            XB_SPIN(xb_ld(&bar[XB_XGEN(b.x)]) == gen, bar);
            __builtin_amdgcn_fence(__ATOMIC_ACQUIRE, "agent");
            asm volatile("s_waitcnt vmcnt(0)" ::: "memory");
        }
    }
    __syncthreads();
}

struct Args { const float* in[11]; float* out; unsigned char* ws; double inv[64]; };
constexpr int LDS_BYTES = 147456;
#ifndef PHASES
#define PHASES 127
#endif

__global__ void __launch_bounds__(512) fwd_megakernel(Args args) {
    extern __shared__ __attribute__((aligned(16))) unsigned char lds_raw[];
    LAS unsigned char* lds = (LAS unsigned char*)lds_raw;
    cg::grid_group grid = cg::this_grid();
#define FRESH_IDS int tid_ = threadIdx.x; asm volatile("" : "+v"(tid_)); const int tid = tid_, lane = tid & 63, wave = __builtin_amdgcn_readfirstlane(tid >> 6); (void)lane; (void)wave; (void)tid
    const int G = gridDim.x, bx = blockIdx.x;
    const int vcu = (G % 8 == 0) ? (bx % 8) * (G / 8) + bx / 8 : bx;
    unsigned char* ws = args.ws; unsigned char* dout = (unsigned char*)args.out;
    const float* x = args.in[0]; const float* mem = args.in[1]; const float* g_in = args.in[2]; const float* g_mem = args.in[3];
    const float* w_in = args.in[4]; const float* w_mkv = args.in[5]; const float* w_pa = args.in[6]; const float* w_pb = args.in[7]; const float* w_pm = args.in[8];
    const float* w_out = args.in[9]; const float* g_fin = args.in[10];
    unsigned* ctl = (unsigned*)(ws + WS_CTL);
    volatile LAS unsigned* bst = (volatile LAS unsigned*)(lds + LDS_BYTES - 256);
    if (threadIdx.x < 2) bst[threadIdx.x] = 0u;
    __syncthreads();
    const XcdBarrier xbar = xcd_barrier_post(ctl + 4096, bst); float* ssq = (float*)(ws + WS_SSQ); float* rope = (float*)(ws + WS_ROPE); float* kmp = (float*)(ws + WS_KMP); float* lse = (float*)(ws + WS_LSE);
    bf16_t* WOUT = (bf16_t*)(ws + WS_WOUT); bf16_t* BTG = (bf16_t*)(ws + WS_BTG); bf16_t* BT1 = (bf16_t*)(ws + WS_BT1); bf16_t* OB = (bf16_t*)(ws + WS_OB);
    bf16_t* H = (bf16_t*)(ws + WS_H); bf16_t* PROJ = (bf16_t*)(ws + WS_PROJ); bf16_t* GB = (bf16_t*)(ws + WS_G); bf16_t* MERGED = (bf16_t*)(ws + WS_MERGED);
    bf16_t* Y = (bf16_t*)(dout + DO_Y); bf16_t* MKV = (bf16_t*)(dout + DO_MKV); bf16_t* WCAT = (bf16_t*)(dout + DO_WCAT);

    if (PHASES & 1) {
        FRESH_IDS;
        const int gw = vcu * 8 + wave, NGW = G * 8;
        LAS float* scr = (LAS float*)(lds + wave * 16384);
        constexpr int I1 = 32 * 352, I2 = 32 * 64, I3 = 32 * 192, I4a = 16 * 64, I4b = 8 * 64, I4c = 16 * 64, I5 = 32 * 64;
        constexpr int NIT = I1 + I2 + I3 + I4a + I4b + I4c + I5;
        for (int it = gw; it < NIT; it += NGW) {
            int r = it;
            if (r < I1) { transpose_item<true>(w_in, 17408, 0, BT1, DM, 0, 0, 352, scr, r, lane); continue; } r -= I1;
            if (r < I2) { transpose_item<false>(w_mkv, 2048, 0, BT1, DM, 11264, 0, 64, scr, r, lane); continue; } r -= I2;
            if (r < I3) { transpose_item<false, true>(w_in, 17408, 11264, BTG, LDH, 0, 0, 192, scr, r, lane); continue; } r -= I3;
            if (r < I4a) { transpose_item<false, true>(w_pa, 2048, 0, WCAT, LDH, 0, 0, 64, scr, r, lane); continue; } r -= I4a;
            if (r < I4b) { transpose_item<false, true>(w_pb, 2048, 0, WCAT, LDH, 0, 1024, 64, scr, r, lane); continue; } r -= I4b;
            if (r < I4c) { transpose_item<false, true>(w_pm, 2048, 0, WCAT, LDH, 0, 1536, 64, scr, r, lane); continue; } r -= I4c;
            transpose_item<false, true>(w_out, 2048, 0, WOUT, DM, 0, 0, 64, scr, r, lane);
        }
        for (int m = gw; m < MTOK + MROWS; m += NGW) {
            if (m < MTOK) rms_row(x + (size_t)m * DM, g_in, H + (size_t)m * LDH, lane);
            else rms_row(mem + (size_t)(m - MTOK) * DM, g_mem, H + (size_t)m * LDH, lane);
        }
        for (int e = vcu * 512 + tid; e < SEQ * 64; e += G * 512) {
            const int pos = e >> 6, i = e & 63;
            const double ang = (double)pos * args.inv[i];
            const double kq = rint(ang * 0.63661977236758134308);
            double r = fma(-kq, 1.57079632679489655800e+00, ang); r = fma(-kq, 6.12323399573676603587e-17, r);
            const double r2 = r * r;
            const double sr = r + r * r2 * (-1.0 / 6 + r2 * (1.0 / 120 + r2 * (-1.0 / 5040 + r2 * (1.0 / 362880 + r2 * (-1.0 / 39916800 + r2 * (1.0 / 6227020800.0))))));
            const double cr = 1.0 + r2 * (-0.5 + r2 * (1.0 / 24 + r2 * (-1.0 / 720 + r2 * (1.0 / 40320 + r2 * (-1.0 / 3628800 + r2 * (1.0 / 479001600.0))))));
            const int q = (int)((long long)kq & 3);
            const double cc = (q == 0) ? cr : (q == 1) ? -sr : (q == 2) ? -cr : sr;
            const double ss = (q == 0) ? sr : (q == 1) ? cr : (q == 2) ? -sr : -cr;
            rope[2 * e] = (float)cc; rope[2 * e + 1] = (float)ss;
        }
    }
    xcd_barrier(xbar);
    if (args.ws == nullptr) grid.sync();
    if (PHASES & 2) {
        Sched1 S{(const char*)H, (const char*)BT1, G, bx};
        Epi1 E{PROJ, MKV, kmp, rope};
        pg8::gemm_phase(lds, LDH, DM, S, E);
    }
    xcd_barrier(xbar);
    if ((PHASES & 2) && bx < 64) {
        Sched1m S{(const char*)H, (const char*)BT1, bx};
        Epi1 E{PROJ, MKV, kmp, rope};
        pg8::gemm_phase(lds, LDH, DM, S, E);
        asm volatile("s_waitcnt vmcnt(0)" ::: "memory");
        __syncthreads();
        if (threadIdx.x == 0) {
            __builtin_amdgcn_fence(__ATOMIC_RELEASE, "agent");
            asm volatile("s_waitcnt vmcnt(0)" ::: "memory");
            (void)__hip_atomic_fetch_add(ctl + 96, 1u, __ATOMIC_RELAXED, __HIP_MEMORY_SCOPE_AGENT);
        }
    }
    if (PHASES & 4) {
        AttnC C{PROJ, MKV, kmp, Y, OB, lse};
        attn_phase(lds, C, ctl + 64, ctl + 96);
    }
    xcd_barrier(xbar);
    if (PHASES & 8) {
        FRESH_IDS;
        for (int e = vcu * 512 + tid; e < MTOK * 64; e += G * 512) {
            const int tok = e >> 6, c8 = e & 63, j = c8 >> 4;
            const float l0 = lse[(size_t)tok * 4 + j], l1 = lse[((size_t)MTOK + tok) * 4 + j], l2 = lse[((size_t)2 * MTOK + tok) * 4 + j];
            const float mx = fmaxf(l0, fmaxf(l1, l2));
            float w0 = __builtin_amdgcn_exp2f(l0 - mx), w1 = __builtin_amdgcn_exp2f(l1 - mx), w2 = __builtin_amdgcn_exp2f(l2 - mx);
            const float inv = 1.0f / (w0 + w1 + w2); w0 *= inv; w1 *= inv; w2 *= inv;
            const u32x4 a = *(const u32x4*)(OB + (size_t)tok * 512 + c8 * 8), b = *(const u32x4*)(OB + ((size_t)MTOK + tok) * 512 + c8 * 8), c = *(const u32x4*)(OB + ((size_t)2 * MTOK + tok) * 512 + c8 * 8);
            const u32x4 z = *(const u32x4*)(PROJ + (size_t)tok * LDP + C_ZB + c8 * 8);
            u32x4 w;
            w.x = cvtpk((w0 * bflo(a.x) + w1 * bflo(b.x) + w2 * bflo(c.x)) * bflo(z.x), (w0 * bfhi(a.x) + w1 * bfhi(b.x) + w2 * bfhi(c.x)) * bfhi(z.x));
            w.y = cvtpk((w0 * bflo(a.y) + w1 * bflo(b.y) + w2 * bflo(c.y)) * bflo(z.y), (w0 * bfhi(a.y) + w1 * bfhi(b.y) + w2 * bfhi(c.y)) * bfhi(z.y));
            w.z = cvtpk((w0 * bflo(a.z) + w1 * bflo(b.z) + w2 * bflo(c.z)) * bflo(z.z), (w0 * bfhi(a.z) + w1 * bfhi(b.z) + w2 * bfhi(c.z)) * bfhi(z.z));
            w.w = cvtpk((w0 * bflo(a.w) + w1 * bflo(b.w) + w2 * bflo(c.w)) * bflo(z.w), (w0 * bfhi(a.w) + w1 * bfhi(b.w) + w2 * bfhi(c.w)) * bfhi(z.w));
            *(u32x4*)(Y + (size_t)tok * LDH + 1024 + c8 * 8) = w;
        }
    }
    xcd_barrier(xbar);
    if (PHASES & 16) {
        Sched3 S{(const char*)H, (const char*)BTG, (const char*)Y, (const char*)WCAT, G, vcu};
        Epi3 E{GB, MERGED};
        pg8::gemm_phase(lds, LDH, LDH, S, E);
    }
    xcd_barrier(xbar);
    if (PHASES & 32) {
        Sched4 S{(const char*)MERGED, (const char*)WOUT, G, vcu};
        Epi4 E{x, args.out, (float*)(ctl + 16384), ctl + 32768, g_fin};
        pg8::gemm_phase(lds, DM, DM, S, E);
    }
}

extern "C" void kernel_launch(void* const* d_in, const int* in_sizes, int n_in, void* d_out, int out_size, void* d_ws, size_t ws_size, hipStream_t stream) {
    static int grid_blocks = 0;
    if (grid_blocks == 0) {
        if (n_in != 11 || out_size != MTOK * DM || ws_size < WS_END) { fprintf(stderr, "kernel_launch: unexpected shapes (n_in %d out %d ws %zu)\n", n_in, out_size, ws_size); grid_blocks = -1; return; }
        int dev = 0, cus = 0, per_cu = 0;
        hipGetDevice(&dev);
        hipDeviceGetAttribute(&cus, hipDeviceAttributeMultiprocessorCount, dev);
        if (hipFuncSetAttribute((const void*)fwd_megakernel, hipFuncAttributeMaxDynamicSharedMemorySize, LDS_BYTES) != hipSuccess) { fprintf(stderr, "kernel_launch: hipFuncSetAttribute failed\n"); grid_blocks = -1; return; }
        if (hipOccupancyMaxActiveBlocksPerMultiprocessor(&per_cu, (const void*)fwd_megakernel, 512, LDS_BYTES) != hipSuccess || per_cu < 1) { fprintf(stderr, "kernel_launch: occupancy query gave %d\n", per_cu); per_cu = 1; }
        (void)hipGetLastError();
        grid_blocks = cus * 1;
    }
    if (grid_blocks < 0) return;
    hipMemsetAsync((char*)d_ws + WS_CTL, 0, 163840, stream);
    Args a{};
    for (int i = 0; i < 11; ++i) a.in[i] = (const float*)d_in[i];
    a.out = (float*)d_out; a.ws = (unsigned char*)d_ws;
    for (int i = 0; i < 64; ++i) a.inv[i] = pow(10000.0, -(double)i / 64.0);
    void* kargs[] = {&a};
    hipError_t e = hipLaunchCooperativeKernel((const void*)fwd_megakernel, dim3(grid_blocks), dim3(512), kargs, LDS_BYTES, stream);
    if (e != hipSuccess) fprintf(stderr, "cooperative launch failed: %s (grid %d)\n", hipGetErrorString(e), grid_blocks);
}
```
